# Optimizing an MI355X kernel written in HIP

```python
import math
import jax, jax.numpy as jnp
from jax import lax
import numpy as np

D_MODEL = 1024
BATCH = 2
SEQ = 8192
DEPTH = 2

HEAD_DIM = 64
D_MIX = D_MODEL
BLOCK = 128
NORM_EPS = 1e-5
A_HEADS = 4
A_QK_DIM = HEAD_DIM // 2
A_V_DIM = HEAD_DIM
A_WIDTH = A_HEADS * A_V_DIM
B_HEADS = 8
B_KV_HEADS = 2
B_GROUP = B_HEADS // B_KV_HEADS
B_WIDTH = B_HEADS * HEAD_DIM
WINDOW = 128
C_HEADS = 4
C_WIDTH = C_HEADS * HEAD_DIM
N_ALIBI_HEADS = A_HEADS + B_HEADS

SPLITS = (
    A_HEADS * 2 * A_QK_DIM, A_HEADS * 2 * A_QK_DIM, A_WIDTH, A_WIDTH,
    B_WIDTH, B_KV_HEADS * HEAD_DIM, B_KV_HEADS * HEAD_DIM, B_WIDTH,
    C_WIDTH, C_WIDTH, C_WIDTH, C_WIDTH,
)
D_IN = sum(SPLITS)
SPLIT_POINTS = tuple(int(v) for v in np.cumsum(SPLITS)[:-1])

kernel_name = "hymba_diff_swa_stickbreak_block"


def alibi_slopes():
    s = 2.0 ** (-8.0 * np.arange(1, N_ALIBI_HEADS + 1) / N_ALIBI_HEADS)
    s = s.astype(np.float32)
    return jnp.asarray(s[B_HEADS:]), jnp.asarray(s[:B_HEADS])


def rmsnorm(x, g):
    xf = x.astype(jnp.float32)
    y = xf * lax.rsqrt(jnp.mean(xf * xf, axis=-1, keepdims=True) + NORM_EPS)
    return (y * g.astype(jnp.float32)).astype(x.dtype)


def diff_attention(q, k, v, lam, slopes):
    b, s = q.shape[:2]
    nblk = s // BLOCK
    scale = A_QK_DIM ** -0.5
    kpos = jnp.arange(s)
    qb = q.reshape(b, nblk, BLOCK, A_HEADS, 2, A_QK_DIM).transpose(1, 0, 2, 3, 4, 5)

    def one_block(args):
        qblk, i = args
        qpos = i * BLOCK + jnp.arange(BLOCK)
        sc = jnp.einsum('bqhmd,bkhmd->bhmqk', qblk, k,
                        preferred_element_type=jnp.float32) * scale
        dist = (qpos[:, None] - kpos[None, :]).astype(jnp.float32)
        sc = sc - (slopes[:, None, None, None] * dist)[None]
        sc = jnp.where((dist >= 0)[None, None, None], sc, -jnp.inf)
        p = jax.nn.softmax(sc, axis=-1)
        w = p[:, :, 0] - lam * p[:, :, 1]
        return jnp.einsum('bhqk,bkhd->bqhd', w.astype(v.dtype), v)

    out = lax.map(one_block, (qb, jnp.arange(nblk)))
    return out.transpose(1, 0, 2, 3, 4).reshape(b, s, A_HEADS, A_V_DIM)


def window_attention(q, k, v, sinks, slopes):
    b, s = q.shape[:2]
    nblk = s // BLOCK
    qb = q.reshape(b, nblk, BLOCK, B_KV_HEADS, B_GROUP, HEAD_DIM)

    def banded(t):
        tb = t.reshape(b, nblk, BLOCK, B_KV_HEADS, HEAD_DIM)
        prev = jnp.pad(tb, ((0, 0), (1, 0), (0, 0), (0, 0), (0, 0)))[:, :-1]
        return jnp.concatenate([prev, tb], axis=2)

    kb, vb = banded(k), banded(v)
    sc = jnp.einsum('bnqhgd,bnkhd->bnhgqk', qb, kb,
                    preferred_element_type=jnp.float32) * HEAD_DIM ** -0.5
    qi = jnp.arange(BLOCK)
    kj = jnp.arange(2 * BLOCK) - BLOCK
    dist = qi[:, None] - kj[None, :]
    blk = jnp.arange(nblk)
    valid = ((dist >= 0) & (dist < WINDOW))[None] & \
        ((blk[:, None, None] * BLOCK + kj[None, None, :]) >= 0)
    sl = slopes.reshape(B_KV_HEADS, B_GROUP)
    sc = sc - sl[:, :, None, None] * dist.astype(jnp.float32)
    sc = jnp.where(valid[None, :, None, None], sc, -jnp.inf)
    sink_col = jnp.broadcast_to(
        sinks.reshape(B_KV_HEADS, B_GROUP)[None, None, :, :, None, None].astype(jnp.float32),
        sc.shape[:-1] + (1,))
    p = jax.nn.softmax(jnp.concatenate([sc, sink_col], axis=-1), axis=-1)[..., :-1]
    out = jnp.einsum('bnhgqk,bnkhd->bnqhgd', p.astype(v.dtype), vb)
    return out.reshape(b, s, B_HEADS, HEAD_DIM)


def stick_breaking_attention(q, k, v):
    b, s = q.shape[:2]
    nblk = s // BLOCK
    scale = HEAD_DIM ** -0.5
    kpos = jnp.arange(s)
    qb = q.reshape(b, nblk, BLOCK, C_HEADS, HEAD_DIM).transpose(1, 0, 2, 3, 4)

    def one_block(args):
        qblk, i = args
        qpos = i * BLOCK + jnp.arange(BLOCK)
        z = jnp.einsum('bqhd,bkhd->bhqk', qblk, k,
                       preferred_element_type=jnp.float32) * scale
        past = kpos[None, :] < qpos[:, None]
        log_beta = jax.nn.log_sigmoid(z)
        log_1m_beta = jnp.where(past, jax.nn.log_sigmoid(-z), 0.0)
        tail = lax.cumsum(log_1m_beta, axis=3, reverse=True) - log_1m_beta
        a = jnp.where(past, jnp.exp(log_beta + tail), 0.0)
        return jnp.einsum('bhqk,bkhd->bqhd', a.astype(v.dtype), v)

    out = lax.map(one_block, (qb, jnp.arange(nblk)))
    return out.transpose(1, 0, 2, 3, 4).reshape(b, s, C_HEADS, HEAD_DIM)


def hybrid_layer(x, norm_g, w_in, lq1, lk1, lq2, lk2, subln_g, sinks, w_out, layer_idx):
    b, s, _ = x.shape
    slopes_a, slopes_b = alibi_slopes()
    h = rmsnorm(x, norm_g)
    proj = jnp.einsum('bsd,de->bse', h, w_in)
    (aq, ak, av, ag, bq, bk, bv, bg, cq, ck, cv, cg) = jnp.split(proj, SPLIT_POINTS, axis=-1)

    lambda_init = 0.8 - 0.6 * math.exp(-0.3 * layer_idx)
    lam = (jnp.exp(jnp.sum(lq1.astype(jnp.float32) * lk1.astype(jnp.float32)))
           - jnp.exp(jnp.sum(lq2.astype(jnp.float32) * lk2.astype(jnp.float32)))
           + lambda_init)
    ya = diff_attention(aq.reshape(b, s, A_HEADS, 2, A_QK_DIM),
                        ak.reshape(b, s, A_HEADS, 2, A_QK_DIM),
                        av.reshape(b, s, A_HEADS, A_V_DIM), lam, slopes_a)
    ya = rmsnorm(ya, subln_g) * (1.0 - lambda_init)
    ya = ya.reshape(b, s, A_WIDTH) * jax.nn.silu(ag)

    yb = window_attention(bq.reshape(b, s, B_HEADS, HEAD_DIM),
                          bk.reshape(b, s, B_KV_HEADS, HEAD_DIM),
                          bv.reshape(b, s, B_KV_HEADS, HEAD_DIM), sinks, slopes_b)
    yb = yb.reshape(b, s, B_WIDTH) * jax.nn.silu(bg)

    yc = stick_breaking_attention(cq.reshape(b, s, C_HEADS, HEAD_DIM),
                                  ck.reshape(b, s, C_HEADS, HEAD_DIM),
                                  cv.reshape(b, s, C_HEADS, HEAD_DIM))
    yc = yc.reshape(b, s, C_WIDTH) * jax.nn.silu(cg)

    y = jnp.concatenate([ya, yb, yc], axis=-1)
    return x + jnp.einsum('bse,ed->bsd', y, w_out)


def setup_inputs(seed: int = 0) -> dict:
    key = jax.random.key(seed)
    ks = jax.random.split(key, 12)
    f32 = jnp.float32
    return {
        "x": jax.random.normal(ks[0], (BATCH, SEQ, D_MODEL), f32),
        "norm_g": 1.0 + 0.02 * jax.random.normal(ks[1], (DEPTH, D_MODEL), f32),
        "w_in": jax.random.normal(ks[2], (DEPTH, D_MODEL, D_IN), f32) * D_MODEL ** -0.5,
        "lambda_q1": 0.1 * jax.random.normal(ks[3], (DEPTH, A_QK_DIM), f32),
        "lambda_k1": 0.1 * jax.random.normal(ks[4], (DEPTH, A_QK_DIM), f32),
        "lambda_q2": 0.1 * jax.random.normal(ks[5], (DEPTH, A_QK_DIM), f32),
        "lambda_k2": 0.1 * jax.random.normal(ks[6], (DEPTH, A_QK_DIM), f32),
        "subln_g": 1.0 + 0.02 * jax.random.normal(ks[7], (DEPTH, A_V_DIM), f32),
        "sinks": 0.5 * jax.random.normal(ks[8], (DEPTH, B_HEADS), f32),
        "w_out": jax.random.normal(ks[9], (DEPTH, D_MIX, D_MODEL), f32) * D_MIX ** -0.5,
        "final_g": 1.0 + 0.02 * jax.random.normal(ks[10], (D_MODEL,), f32),
    }


def reference(x, norm_g, w_in, lambda_q1, lambda_k1, lambda_q2, lambda_k2, subln_g, sinks, w_out, final_g):
    for l in range(DEPTH):
        x = hybrid_layer(x, norm_g[l], w_in[l], lambda_q1[l], lambda_k1[l], lambda_q2[l],
                         lambda_k2[l], subln_g[l], sinks[l], w_out[l], l)
    return rmsnorm(x, final_g)
```

```cpp
#include <hip/hip_runtime.h>
#include <hip/hip_cooperative_groups.h>
#include <cstdio>
namespace cg = cooperative_groups;

#define DI __device__ __forceinline__
#define LAS __attribute__((address_space(3)))
typedef unsigned short u16;
typedef __attribute__((ext_vector_type(8))) __bf16 bf16x8;
typedef __attribute__((ext_vector_type(2))) __bf16 bf16x2;
typedef __attribute__((ext_vector_type(16))) float f32x16;
typedef __attribute__((ext_vector_type(2))) float f32x2;
typedef __attribute__((ext_vector_type(4))) unsigned u32x4;
typedef __attribute__((ext_vector_type(2))) unsigned u32x2;
typedef __attribute__((ext_vector_type(4))) float f32x4;

constexpr int SEQ = 8192, NBATCH = 2, DM = 1024, MTOK = NBATCH * SEQ, DIN = 3328, DEPTH = 2, NVH = 10;
constexpr float EPS = 1e-5f, LOG2E = 1.4426950408889634f;
constexpr int LSTR = 72;
constexpr int SMEM_U16 = 8 * 64 * LSTR;
constexpr int N_ITEMS_XCD = 128 + 64 + 64;
#ifndef REP_PREP
#define REP_PREP 1
#endif
#ifndef REP_G0
#define REP_G0 1
#endif
#ifndef REP_ATT
#define REP_ATT 1
#endif
#ifndef REP_LO
#define REP_LO 0
#endif
#ifndef REP_HI
#define REP_HI N_ITEMS_XCD
#endif

struct Params {
  const float *x, *norm_g, *w_in, *lq1, *lk1, *lq2, *lk2, *subln_g, *sinks, *w_out, *final_g;
  float* out;
  u16* wtin;
  u16* wtout;
  u16* xg;
  u16* proj;
  u16* vt;
  u16* y;
  float* ss;
  unsigned* ctr;
  unsigned* bar;
  float* x2;
  size_t never;
};

DI unsigned pk2(float a, float b) {
  f32x2 v = {a, b};
  bf16x2 r = __builtin_convertvector(v, bf16x2);
  return __builtin_bit_cast(unsigned, r);
}
DI uint2 pk4(float a, float b, float c, float d) { uint2 r; r.x = pk2(a, b); r.y = pk2(c, d); return r; }
DI float bflo(unsigned v) { return __uint_as_float(v << 16); }
DI float bfhi(unsigned v) { return __uint_as_float(v & 0xffff0000u); }
DI float ex2(float x) { return __builtin_amdgcn_exp2f(x); }

DI float lg2(float x) { return __builtin_amdgcn_logf(x); }
DI f32x16 mfma(bf16x8 a, bf16x8 b, f32x16 c) { return __builtin_amdgcn_mfma_f32_32x32x16_bf16(a, b, c, 0, 0, 0); }
DI bf16x8 ldsv(const u16* p) { return *(const bf16x8*)p; }
DI float silu(float g) { return g * __builtin_amdgcn_rcpf(1.f + ex2(-g * LOG2E)); }
DI int tid_now(int wv) {
  int t;
  asm volatile("v_mbcnt_lo_u32_b32 %0, -1, 0\n\tv_mbcnt_hi_u32_b32 %0, -1, %0" : "=v"(t));
  return wv * 64 + t;
}
DI float shx(float v, int lane, int o = 32) {
  return __int_as_float(__builtin_amdgcn_ds_bpermute((lane ^ o) << 2, __float_as_int(v)));
}
template <typename T> DI volatile LAS T* lds_fresh(volatile LAS T* q) { asm volatile("" : "+v"(q)); return q; }
DI float wave_sum(float v, int lane) {
#pragma unroll
  for (int o = 32; o >= 1; o >>= 1) v += shx(v, lane, o);
  return v;
}


#define XB_TMO      128
#define XB_XCNT(j)  (256  + 64 * (j))
#define XB_XSUB(j)  (1280 + 64 * (j))
#define XB_XGEN(j)  (2304 + 64 * (j))
#define XB_TOP      3328
#define XB_TOPGEN   3392
#define XCD_BAR_WORDS 3456
#define XB_SPIN_CAP (1u << 18)
DI unsigned xb_ld(unsigned* p) { return __hip_atomic_load(p, __ATOMIC_RELAXED, __HIP_MEMORY_SCOPE_AGENT); }
DI unsigned xb_add(unsigned* p, unsigned v) { return __hip_atomic_fetch_add(p, v, __ATOMIC_RELAXED, __HIP_MEMORY_SCOPE_AGENT); }
DI unsigned xb_xcc_id() { return (unsigned)__builtin_amdgcn_s_getreg((3 << 11) | 20) & 0xFu; }
#define XB_SPIN(cond, bar) do { unsigned _sp = 0; while (cond) { __builtin_amdgcn_s_sleep(1); \
    if ((++_sp & 255u) == 0u) { if (xb_ld(&(bar)[XB_TMO])) break; if (_sp > XB_SPIN_CAP) { atomicAdd(&(bar)[XB_TMO], 1u); break; } } } } while (0)
struct XcdBarrier { unsigned* bar; unsigned x; volatile LAS unsigned* st; int wv; };
DI XcdBarrier xcd_barrier_post(unsigned* bar, volatile LAS unsigned* st, int wv) {
  XcdBarrier b; b.bar = bar; b.x = xb_xcc_id(); b.st = st; b.wv = wv;
  if (tid_now(wv) == 0) (void)xb_add(&bar[XB_XCNT(b.x)], 1u);
  return b;
}
DI void xcd_barrier_complete(unsigned* bar, unsigned x, unsigned& nloc, unsigned& nx) {
  const unsigned G = gridDim.x * gridDim.y * gridDim.z;
  unsigned sum, cnt, mine, sp = 0u;
  for (;;) {
    sum = 0u; cnt = 0u; mine = 0u;
#pragma unroll
    for (unsigned j = 0; j < 16; ++j) { const unsigned c = xb_ld(&bar[XB_XCNT(j)]); sum += c; cnt += (c > 0u) ? 1u : 0u; mine = (j == x) ? c : mine; }
    if (sum == G) break;
    __builtin_amdgcn_s_sleep(1);
    if ((++sp & 255u) == 0u) { if (xb_ld(&bar[XB_TMO])) break; if (sp > XB_SPIN_CAP) { atomicAdd(&bar[XB_TMO], 1u); break; } }
  }
  nloc = mine > 0u ? mine : 1u; nx = cnt > 0u ? cnt : 1u;
}
DI void xcd_barrier(const XcdBarrier& b) {
  asm volatile("s_waitcnt vmcnt(0)" ::: "memory");
  __syncthreads();
  if (tid_now(b.wv) == 0) {
    unsigned* bar = b.bar;
    __builtin_amdgcn_s_waitcnt(0);
    volatile LAS unsigned* st = lds_fresh(b.st);
    unsigned nloc = st[0], nx = st[1];
    if (nloc == 0u) { xcd_barrier_complete(bar, b.x, nloc, nx); st[0] = nloc; st[1] = nx; }
    const unsigned old = xb_add(&bar[XB_XSUB(b.x)], 1u);
    const unsigned gen = old / nloc;
    if (old + 1u == (gen + 1u) * nloc) {
      __builtin_amdgcn_fence(__ATOMIC_RELEASE, "agent");
      asm volatile("s_waitcnt vmcnt(0)" ::: "memory");
      const unsigned og = xb_add(&bar[XB_TOP], 1u);
      const unsigned tg = og / nx;
      if (og + 1u == (tg + 1u) * nx) xb_add(&bar[XB_TOPGEN], 1u);
      else XB_SPIN(xb_ld(&bar[XB_TOPGEN]) == tg, bar);
      __builtin_amdgcn_fence(__ATOMIC_ACQUIRE, "agent");
      xb_add(&bar[XB_XGEN(b.x)], 1u);
      asm volatile("s_waitcnt vmcnt(0)" ::: "memory");
    } else {
      XB_SPIN(xb_ld(&bar[XB_XGEN(b.x)]) == gen, bar);
      __builtin_amdgcn_fence(__ATOMIC_ACQUIRE, "agent");
      asm volatile("s_waitcnt vmcnt(0)" ::: "memory");
    }
  }
  __syncthreads();
}

DI void phase_prep(const Params& p, u16* sm, int wv) {
  const int tid = tid_now(wv), nb = gridDim.x, bid = blockIdx.x;
  float* smf = (float*)sm;
  constexpr int T_IN = DEPTH * 16 * 52, T_OUT = DEPTH * 16 * 16;
  for (int t = bid; t < T_IN + T_OUT; t += nb) {
    const float* src; u16* dst; int N, kt, nt; const float* gsc = nullptr;
    if (t < T_IN) {
      int l = t / 832, rr = t % 832; kt = rr / 52; nt = rr % 52; N = DIN;
      src = p.w_in + (size_t)l * 1024 * DIN; dst = p.wtin + (size_t)l * DIN * 1024; gsc = p.norm_g + l * DM;
    } else {
      int u = t - T_IN; int l = u / 256, rr = u % 256; kt = rr / 16; nt = rr % 16; N = 1024;
      src = p.w_out + (size_t)l * 1024 * 1024; dst = p.wtout + (size_t)l * 1024 * 1024;
    }
    __syncthreads();
#pragma unroll
    for (int i = 0; i < 4; ++i) {
      const int k = i * 16 + (tid >> 4), n4 = (tid & 15) * 4;
      const f32x4 v = *(const f32x4*)(src + (size_t)(kt * 64 + k) * N + nt * 64 + n4);
      const float gk = gsc ? gsc[kt * 64 + k] : 1.f;
      smf[(n4 + 0) * 65 + k] = v[0] * gk; smf[(n4 + 1) * 65 + k] = v[1] * gk;
      smf[(n4 + 2) * 65 + k] = v[2] * gk; smf[(n4 + 3) * 65 + k] = v[3] * gk;
    }
    __syncthreads();
#pragma unroll
    for (int j = 0; j < 2; ++j) {
      const int c = tid + 256 * j, kc = c & 7, n = c >> 3;
      const float* q = smf + n * 65 + kc * 8;
      u32x4 o = {pk2(q[0], q[1]), pk2(q[2], q[3]), pk2(q[4], q[5]), pk2(q[6], q[7])};
      *(u32x4*)(dst + (size_t)(nt * 64 + n) * 1024 + kt * 64 + kc * 8) = o;
    }
  }
  const int lane = tid & 63;
  {
    for (int row0 = (bid * 4 + (tid >> 6)) * 4; row0 < MTOK; row0 += nb * 16) {
      f32x4 xv[4][4];
#pragma unroll
      for (int q = 0; q < 4; ++q)
#pragma unroll
        for (int j = 0; j < 4; ++j) xv[q][j] = *(const f32x4*)(p.x + (size_t)(row0 + q) * DM + j * 256 + lane * 4);
#pragma unroll
      for (int q = 0; q < 4; ++q) {
        float sq = 0.f;
#pragma unroll
        for (int j = 0; j < 4; ++j) {
          const f32x4 v = xv[q][j];
          sq += v[0] * v[0] + v[1] * v[1] + v[2] * v[2] + v[3] * v[3];
          u32x2 o = {pk2(v[0], v[1]), pk2(v[2], v[3])};
          *(u32x2*)(p.xg + (size_t)(row0 + q) * DM + j * 256 + lane * 4) = o;
        }
        sq = wave_sum(sq, lane);
        if (lane == 0) p.ss[row0 + q] = sq;
      }
    }
  }
  for (int i = bid * 256 + tid; i < 2 * MTOK; i += nb * 256) p.ss[MTOK + i] = 0.f;
  if (bid == 0 && tid < 64) p.ctr[tid] = 0u;
}

constexpr int GSTR = 80;
DI f32x4 mfma16(bf16x8 a, bf16x8 b, f32x4 c) { return __builtin_amdgcn_mfma_f32_16x16x32_bf16(a, b, c, 0, 0, 0); }

template <bool VT>
DI void gemm_kslab(f32x4 (&acc)[8][4], const u16* sA, const u16* sB, int wm, int wn, int fr, int fq) {
#pragma unroll
  for (int ks = 0; ks < 2; ++ks) {
    bf16x8 tb[4], ta[8];
#pragma unroll
    for (int j = 0; j < 4; ++j) tb[j] = ldsv(sB + (wn * 64 + 16 * j + fr) * GSTR + ks * 32 + 8 * fq);
#pragma unroll
    for (int i = 0; i < 8; ++i) ta[i] = ldsv(sA + (wm * 128 + 16 * i + fr) * GSTR + ks * 32 + 8 * fq);
#pragma unroll
    for (int i = 0; i < 8; ++i)
#pragma unroll
      for (int j = 0; j < 4; ++j)
        acc[i][j] = VT ? mfma16(ta[i], tb[j], acc[i][j]) : mfma16(tb[j], ta[i], acc[i][j]);
  }
  __builtin_amdgcn_sched_group_barrier(0x100, 6, 0);
#pragma unroll
  for (int g = 0; g < 6; ++g) {
    __builtin_amdgcn_sched_group_barrier(0x008, 4, 0);
    __builtin_amdgcn_sched_group_barrier(0x100, 1, 0);
  }
  __builtin_amdgcn_sched_group_barrier(0x100, 6, 0);
  __builtin_amdgcn_sched_group_barrier(0x008, 8, 0);
#pragma unroll
  for (int g = 0; g < 6; ++g) {
    __builtin_amdgcn_sched_group_barrier(0x008, 4, 0);
    __builtin_amdgcn_sched_group_barrier(0x100, 1, 0);
  }
  __builtin_amdgcn_sched_group_barrier(0x008, 8, 0);
}

template <bool VT>
DI void gemm_mainloop(f32x4 (&acc)[8][4], const char* abase, const char* bbase, unsigned toff, u16* sA, u16* sB, int loff, int wm, int wn, int fr, int fq) {
  const __amdgpu_buffer_rsrc_t ra_rs = __builtin_amdgcn_make_buffer_rsrc((void*)abase, (short)0, 256 * 2048, 0x00020000);
  const __amdgpu_buffer_rsrc_t rb_rs = __builtin_amdgcn_make_buffer_rsrc((void*)bbase, (short)0, 128 * 2048, 0x00020000);
  u32x4 ra[8], rb[4];
#pragma unroll
  for (int i = 0; i < 8; ++i) ra[i] = __builtin_amdgcn_raw_buffer_load_b128(ra_rs, (int)toff, i * 65536, 0);
#pragma unroll
  for (int i = 0; i < 4; ++i) rb[i] = __builtin_amdgcn_raw_buffer_load_b128(rb_rs, (int)toff, i * 65536, 0);
#pragma unroll 1
  for (int kt = 0; kt < 16; ++kt) {
    __syncthreads();
#pragma unroll
    for (int i = 0; i < 8; ++i) *(u32x4*)(sA + loff + i * 32 * GSTR) = ra[i];
#pragma unroll
    for (int i = 0; i < 4; ++i) *(u32x4*)(sB + loff + i * 32 * GSTR) = rb[i];
    if (kt + 1 < 16) {
      const int ko = (kt + 1) * 128;
#pragma unroll
      for (int i = 0; i < 8; ++i) ra[i] = __builtin_amdgcn_raw_buffer_load_b128(ra_rs, (int)toff, i * 65536 + ko, 0);
#pragma unroll
      for (int i = 0; i < 4; ++i) rb[i] = __builtin_amdgcn_raw_buffer_load_b128(rb_rs, (int)toff, i * 65536 + ko, 0);
    }
    __syncthreads();
    gemm_kslab<VT>(acc, sA, sB, wm, wn, fr, fq);
  }
}

template <int EPI>
DI void gemm_tile(const Params& p, int layer, int mt, int nt, u16* sm, int wv) {
  const int tid = tid_now(wv), w = tid >> 6;
  int lane = tid & 63, fr = lane & 15, fq = lane >> 4;
  const u16* A = (EPI == 0) ? p.xg : p.y;
  const u16* Bt = (EPI == 0) ? p.wtin + (size_t)layer * DIN * 1024 : p.wtout + (size_t)layer * 1024 * 1024;
  const int m0 = mt * 256, n0 = nt * 128;
  const char* abase = (const char*)(A + (size_t)m0 * 1024);
  const char* bbase = (const char*)(Bt + (size_t)n0 * 1024);
  const unsigned toff = (unsigned)(tid >> 3) * 2048u + (unsigned)(tid & 7) * 16u;
  const int loff = (tid >> 3) * GSTR + (tid & 7) * 8;
  u16* sA = sm;
  u16* sB = sm + 256 * GSTR;
  f32x4 acc[8][4];
#pragma unroll
  for (int i = 0; i < 8; ++i)
#pragma unroll
    for (int j = 0; j < 4; ++j)
#pragma unroll
      for (int e = 0; e < 4; ++e) acc[i][j][e] = 0.f;

  bool vtile = false;
  if (EPI == 0) vtile = (nt == 4 || nt == 5 || nt == 13 || nt == 22 || nt == 23);
  int wm = w >> 1, wn = w & 1;

  if (EPI == 0 && vtile) { asm volatile("; v-tile main loop" ::: "memory"); gemm_mainloop<true>(acc, abase, bbase, toff, sA, sB, loff, wm, wn, fr, fq); }
  else { asm volatile("; main loop" ::: "memory"); gemm_mainloop<false>(acc, abase, bbase, toff, sA, sB, loff, wm, wn, fr, fq); }

  {
    const int t2 = tid_now(wv);
    const int l2 = t2 & 63, w2 = t2 >> 6;
    lane = l2; fr = l2 & 15; fq = l2 >> 4; wm = w2 >> 1; wn = w2 & 1;
  }
  if (EPI == 0) {
    const float* ssl = p.ss + (size_t)layer * MTOK;
    __syncthreads();
    u16* stg = sm + (wm * 2 + wn) * (128 * LSTR);
    if (!vtile) {
      const float qsc = (nt < 2) ? 0.17677669529663687f * LOG2E
                        : ((nt >= 8 && nt < 12) || nt == 18 || nt == 19) ? 0.125f * LOG2E : 1.f;
#pragma unroll
      for (int i = 0; i < 8; ++i) {
        const int m = m0 + wm * 128 + 16 * i + fr;
        const float rs = __builtin_amdgcn_rsqf(ssl[m] * (1.f / DM) + EPS) * qsc;
        u16* d = stg + (16 * i + fr) * LSTR + 4 * fq;
#pragma unroll
        for (int j = 0; j < 4; ++j) {
          u32x2 v = {pk2(acc[i][j][0] * rs, acc[i][j][1] * rs), pk2(acc[i][j][2] * rs, acc[i][j][3] * rs)};
          *(u32x2*)(d + 16 * j) = v;
        }
      }
      u16* gdst = p.proj + (size_t)(m0 + wm * 128) * DIN + n0 + wn * 64;
#pragma unroll
      for (int t = 0; t < 16; ++t) {
        const int c = lane + 64 * t, row = c >> 3, kc = c & 7;
        const u32x4 v = *(const u32x4*)(stg + row * LSTR + kc * 8);
        *(u32x4*)(gdst + (size_t)row * DIN + kc * 8) = v;
      }
    } else {
      const int vbase = (nt == 4) ? 0 : (nt == 5) ? 2 : (nt == 13) ? 4 : (nt == 22) ? 6 : 8;
      const int bb = m0 / SEQ, s0 = m0 % SEQ;
      constexpr int VSTR = 136;
#pragma unroll
      for (int i = 0; i < 8; ++i) {
        float rs[4];
#pragma unroll
        for (int e = 0; e < 4; ++e) rs[e] = __builtin_amdgcn_rsqf(ssl[m0 + wm * 128 + 16 * i + 4 * fq + e] * (1.f / DM) + EPS);
        const int pos = 16 * i + 8 * (fq & 1) + 4 * (fq >> 1);
#pragma unroll
        for (int j = 0; j < 4; ++j) {
          u32x2 v = {pk2(acc[i][j][0] * rs[0], acc[i][j][1] * rs[1]), pk2(acc[i][j][2] * rs[2], acc[i][j][3] * rs[3])};
          *(u32x2*)(stg + (16 * j + fr) * VSTR + pos) = v;
        }
      }
      u16* gdst = p.vt + ((size_t)(bb * NVH + vbase + wn) * 64) * SEQ + s0 + wm * 128;
#pragma unroll
      for (int t = 0; t < 16; ++t) {
        const int c = lane + 64 * t, row = c >> 4, kc = c & 15;
        const u32x4 v = *(const u32x4*)(stg + row * VSTR + kc * 8);
        *(u32x4*)(gdst + (size_t)row * SEQ + kc * 8) = v;
      }
    }
  } else {
    const bool has_next = (layer + 1 < DEPTH);
    float* ssn = p.ss + (size_t)(layer + 1) * MTOK;
    __syncthreads();
    float* stg = (float*)(sm + (wm * 2 + wn) * (128 * LSTR));
    const int kc = lane & 15;
#pragma unroll
    for (int hh = 0; hh < 2; ++hh) {
#pragma unroll
      for (int i2 = 0; i2 < 4; ++i2)
#pragma unroll
        for (int j = 0; j < 4; ++j)
          *(f32x4*)(stg + (16 * i2 + fr) * 68 + 16 * j + 4 * fq) = acc[4 * hh + i2][j];
      const size_t mrow0 = (size_t)(m0 + wm * 128 + 64 * hh);
      u16* xrow = p.xg + mrow0 * DM + n0 + wn * 64 + kc * 4;
      u16* x2row = (u16*)p.x2 + mrow0 * DM + n0 + wn * 64 + kc * 4;
      u32x2 xb[16];
#pragma unroll
      for (int t = 0; t < 16; ++t) xb[t] = *(const u32x2*)(xrow + (size_t)((lane >> 4) + 4 * t) * DM);
#pragma unroll
      for (int t = 0; t < 16; ++t) {
        const int row = (lane >> 4) + 4 * t;
        const f32x4 a4 = *(const f32x4*)(stg + row * 68 + kc * 4);
        const float v0 = bflo(xb[t][0]) + a4[0], v1 = bfhi(xb[t][0]) + a4[1], v2 = bflo(xb[t][1]) + a4[2], v3 = bfhi(xb[t][1]) + a4[3];
        float sq = v0 * v0 + v1 * v1 + v2 * v2 + v3 * v3;
        u32x2 pv = {pk2(v0, v1), pk2(v2, v3)};
        if (has_next) *(u32x2*)(xrow + (size_t)row * DM) = pv;
        else *(u32x2*)(x2row + (size_t)row * DM) = pv;
        sq += shx(sq, lane, 1); sq += shx(sq, lane, 2); sq += shx(sq, lane, 4); sq += shx(sq, lane, 8);
        if (kc == 0) atomicAdd(ssn + mrow0 + row, sq);
      }
    }
  }
}

template <int MODE, int KS0, int NKS>
DI void qk_scores(f32x16& s0, f32x16& s1, const u16* Ks, const bf16x8 (&qf)[4], float sl2, int dl, float mref,
                  bool need_mask, int r, int h, int rs, const int (&lo)[4]) {
  asm volatile("" : "+v"(dl));
  const float nb = -sl2 * (float)dl - mref;
#pragma unroll
  for (int i = 0; i < 16; ++i) {
    const int ci = (i & 3) + 8 * (i >> 2);
    s0[i] = fmaf(sl2, (float)ci, nb);
    s1[i] = fmaf(sl2, (float)(ci + 32), nb);
  }
#pragma unroll
  for (int ks = 0; ks < NKS; ++ks) {
    bf16x8 k0 = ldsv(Ks + lo[KS0 + ks]);
    bf16x8 k1 = ldsv(Ks + 32 * rs + lo[KS0 + ks]);
    s0 = mfma(k0, qf[KS0 + ks], s0);
    s1 = mfma(k1, qf[KS0 + ks], s1);
  }
  if (need_mask) {
#pragma unroll
    for (int i = 0; i < 16; ++i) {
      const int ci = (i & 3) + 8 * (i >> 2);
      bool v0 = (MODE == 0) ? (ci <= dl) : (ci <= dl && ci > dl - 128);
      bool v1 = (MODE == 0) ? (ci + 32 <= dl) : (ci + 32 <= dl && ci + 32 > dl - 128);
      s0[i] = v0 ? s0[i] : -INFINITY;
      s1[i] = v1 ? s1[i] : -INFINITY;
    }
  }
}
template <int MODE, int KS0, int NKS>
DI void softmax_pv(const bf16x8 (&qf)[4], const u16* Ks, const u16* Vs, float& m, f32x16& ls, f32x16& o0, f32x16& o1,
                   float sl2, int dl, bool need_mask, bool first, int r, int h, int rs, const int (&lo)[4]) {
  f32x16 s0, s1;
  qk_scores<MODE, KS0, NKS>(s0, s1, Ks, qf, sl2, dl, m, need_mask, r, h, rs, lo);
  if (__any(first || !(ls[0] <= 1.0e12f))) {
    float tmax = -INFINITY;
#pragma unroll
    for (int i = 0; i < 16; ++i) tmax = fmaxf(tmax, fmaxf(s0[i], s1[i]));
    tmax = fmaxf(tmax, shx(tmax, r + 32 * h));
    const float lref = (ls[0] > 1.f) ? lg2(ls[0]) : 0.f;
    const float delta = first ? tmax : fmaxf(fmaxf(tmax, lref), 0.f);
    m += delta;
    const float alpha = ex2(-delta);
#pragma unroll
    for (int e = 0; e < 16; ++e) { o0[e] *= alpha; o1[e] *= alpha; ls[e] *= alpha; }
#pragma unroll
    for (int i = 0; i < 16; ++i) { s0[i] -= delta; s1[i] -= delta; }
  }
#pragma unroll
  for (int i = 0; i < 16; ++i) { s0[i] = ex2(s0[i]); s1[i] = ex2(s1[i]); }
  const u32x4 one4 = {0x3f803f80u, 0x3f803f80u, 0x3f803f80u, 0x3f803f80u};
  const bf16x8 ones = __builtin_bit_cast(bf16x8, one4);
#pragma unroll
  for (int kk = 0; kk < 4; ++kk) {
    const int s = kk & 1;
    unsigned u0, u1, u2, u3;
    if (kk < 2) {
      u0 = pk2(s0[8 * s], s0[8 * s + 1]); u1 = pk2(s0[8 * s + 2], s0[8 * s + 3]);
      u2 = pk2(s0[8 * s + 4], s0[8 * s + 5]); u3 = pk2(s0[8 * s + 6], s0[8 * s + 7]);
    } else {
      u0 = pk2(s1[8 * s], s1[8 * s + 1]); u1 = pk2(s1[8 * s + 2], s1[8 * s + 3]);
      u2 = pk2(s1[8 * s + 4], s1[8 * s + 5]); u3 = pk2(s1[8 * s + 6], s1[8 * s + 7]);
    }
    u32x4 uu = {u0, u1, u2, u3};
    bf16x8 pf = __builtin_bit_cast(bf16x8, uu);
    bf16x8 v0 = ldsv(Vs + lo[kk]);
    bf16x8 v1 = ldsv(Vs + 32 * rs + lo[kk]);
    o0 = mfma(v0, pf, o0);
    o1 = mfma(v1, pf, o1);
    ls = mfma(ones, pf, ls);
  }
}

DI void pv_frag_step(f32x16& s0, f32x16& s1, const u16* Vs, f32x16& o0, f32x16& o1, f32x16& ls, int rs, const int (&lo)[4]) {
  const u32x4 one4 = {0x3f803f80u, 0x3f803f80u, 0x3f803f80u, 0x3f803f80u};
  const bf16x8 ones = __builtin_bit_cast(bf16x8, one4);
#pragma unroll
  for (int i = 0; i < 16; ++i) { s0[i] = ex2(s0[i]); s1[i] = ex2(s1[i]); }
#pragma unroll
  for (int kk = 0; kk < 4; ++kk) {
    const int s = kk & 1;
    unsigned u0, u1, u2, u3;
    if (kk < 2) {
      u0 = pk2(s0[8 * s], s0[8 * s + 1]); u1 = pk2(s0[8 * s + 2], s0[8 * s + 3]);
      u2 = pk2(s0[8 * s + 4], s0[8 * s + 5]); u3 = pk2(s0[8 * s + 6], s0[8 * s + 7]);
    } else {
      u0 = pk2(s1[8 * s], s1[8 * s + 1]); u1 = pk2(s1[8 * s + 2], s1[8 * s + 3]);
      u2 = pk2(s1[8 * s + 4], s1[8 * s + 5]); u3 = pk2(s1[8 * s + 6], s1[8 * s + 7]);
    }
    u32x4 uu = {u0, u1, u2, u3};
    bf16x8 pf = __builtin_bit_cast(bf16x8, uu);
    bf16x8 v0 = ldsv(Vs + lo[kk]);
    bf16x8 v1 = ldsv(Vs + 32 * rs + lo[kk]);
    o0 = mfma(v0, pf, o0);
    o1 = mfma(v1, pf, o1);
    ls = mfma(ones, pf, ls);
  }
}
DI void mask_causal(f32x16& s0, f32x16& s1, int dl) {
#pragma unroll
  for (int i = 0; i < 16; ++i) {
    const int ci = (i & 3) + 8 * (i >> 2);
    s0[i] = (ci <= dl) ? s0[i] : -INFINITY;
    s1[i] = (ci + 32 <= dl) ? s1[i] : -INFINITY;
  }
}
DI void diff_softmax_pv(const bf16x8 (&qf)[4], const u16* Ks, const u16* Vs, float& m, f32x16& ls0, f32x16& ls1,
                        f32x16 (&o)[2][2], float sl2, int dl, bool need_mask, bool first, int r, int h, int rs, const int (&lo)[4]) {
  f32x16 b0, b1;
  const float nb = -sl2 * (float)dl - m;
#pragma unroll
  for (int i = 0; i < 16; ++i) {
    const int ci = (i & 3) + 8 * (i >> 2);
    b0[i] = fmaf(sl2, (float)ci, nb);
    b1[i] = fmaf(sl2, (float)(ci + 32), nb);
  }
  {
    f32x16 s0 = mfma(ldsv(Ks + lo[0]), qf[0], b0);
    f32x16 s1 = mfma(ldsv(Ks + 32 * rs + lo[0]), qf[0], b1);
    s0 = mfma(ldsv(Ks + lo[1]), qf[1], s0);
    s1 = mfma(ldsv(Ks + 32 * rs + lo[1]), qf[1], s1);
    if (need_mask) mask_causal(s0, s1, dl);
    if (__any(first || !(ls0[0] <= 1.0e12f) || !(ls1[0] <= 1.0e12f))) {
      float tmax = -INFINITY;
#pragma unroll
      for (int i = 0; i < 16; ++i) tmax = fmaxf(tmax, fmaxf(s0[i], s1[i]));
      tmax = fmaxf(tmax, shx(tmax, r + 32 * h));
      const float lmx = fmaxf(ls0[0], ls1[0]);
      const float lref = (lmx > 1.f) ? lg2(lmx) : 0.f;
      const float delta = first ? tmax : fmaxf(fmaxf(tmax, lref), 0.f);
      m += delta;
      const float alpha = ex2(-delta);
#pragma unroll
      for (int e = 0; e < 16; ++e) {
        o[0][0][e] *= alpha; o[0][1][e] *= alpha; o[1][0][e] *= alpha; o[1][1][e] *= alpha;
        ls0[e] *= alpha; ls1[e] *= alpha;
        s0[e] -= delta; s1[e] -= delta; b0[e] -= delta; b1[e] -= delta;
      }
    }
    pv_frag_step(s0, s1, Vs, o[0][0], o[0][1], ls0, rs, lo);
  }
  {
    f32x16 s0 = mfma(ldsv(Ks + lo[2]), qf[2], b0);
    f32x16 s1 = mfma(ldsv(Ks + 32 * rs + lo[2]), qf[2], b1);
    s0 = mfma(ldsv(Ks + lo[3]), qf[3], s0);
    s1 = mfma(ldsv(Ks + 32 * rs + lo[3]), qf[3], s1);
    if (need_mask) mask_causal(s0, s1, dl);
    pv_frag_step(s0, s1, Vs, o[1][0], o[1][1], ls1, rs, lo);
  }
}

DI void stick_pv(f32x16& s0, f32x16& s1, float& R, f32x16& o0, f32x16& o1, const u16* Vs, int dl,
                 bool need_mask, int r, int h) {
  float x[32];
#pragma unroll
  for (int t = 0; t < 2; ++t)
#pragma unroll
    for (int i = 0; i < 16; ++i) {
      const int ci = 32 * t + (i & 3) + 8 * (i >> 2);
      float a = t ? s1[i] : s0[i];
      float z = __builtin_amdgcn_fmed3f(a, -126.f, 126.f);
      float e = ex2(-z);
      float lb = -lg2(1.f + e);
      float xi = lb - z;
      if (need_mask) {
        bool valid = (ci < dl);
        xi = valid ? xi : 0.f;
        lb = valid ? lb : -INFINITY;
      }
      x[16 * t + i] = xi;
      if (t) s1[i] = lb; else s0[i] = lb;
    }
  float gs[8], pg[8], pr[8];
#pragma unroll
  for (int g = 0; g < 8; ++g) {
    gs[g] = (x[4 * g] + x[4 * g + 1]) + (x[4 * g + 2] + x[4 * g + 3]);
    pg[g] = shx(gs[g], r + 32 * h);
    pr[g] = gs[g] + pg[g];
  }
  float suf = 0.f;
#pragma unroll
  for (int g = 7; g >= 0; --g) {
    float base = R + suf + (h == 0 ? pg[g] : 0.f);
    float t3 = base, t2 = t3 + x[4 * g + 3], t1 = t2 + x[4 * g + 2], t0 = t1 + x[4 * g + 1];
    const int i = 4 * (g & 3);
    if (g >= 4) {
      s1[i] = ex2(s1[i] + t0); s1[i + 1] = ex2(s1[i + 1] + t1); s1[i + 2] = ex2(s1[i + 2] + t2); s1[i + 3] = ex2(s1[i + 3] + t3);
    } else {
      s0[i] = ex2(s0[i] + t0); s0[i + 1] = ex2(s0[i + 1] + t1); s0[i + 2] = ex2(s0[i + 2] + t2); s0[i + 3] = ex2(s0[i + 3] + t3);
    }
    suf += pr[g];
  }
  R += suf;
#pragma unroll
  for (int kk = 0; kk < 4; ++kk) {
    const int s = kk & 1;
    unsigned u0, u1, u2, u3;
    if (kk < 2) {
      u0 = pk2(s0[8 * s], s0[8 * s + 1]); u1 = pk2(s0[8 * s + 2], s0[8 * s + 3]);
      u2 = pk2(s0[8 * s + 4], s0[8 * s + 5]); u3 = pk2(s0[8 * s + 6], s0[8 * s + 7]);
    } else {
      u0 = pk2(s1[8 * s], s1[8 * s + 1]); u1 = pk2(s1[8 * s + 2], s1[8 * s + 3]);
      u2 = pk2(s1[8 * s + 4], s1[8 * s + 5]); u3 = pk2(s1[8 * s + 6], s1[8 * s + 7]);
    }
    u32x4 uu = {u0, u1, u2, u3};
    bf16x8 pf = __builtin_bit_cast(bf16x8, uu);
    bf16x8 v0 = ldsv(Vs + r * LSTR + kk * 16 + 8 * h);
    bf16x8 v1 = ldsv(Vs + (32 + r) * LSTR + kk * 16 + 8 * h);
    o0 = mfma(v0, pf, o0);
    o1 = mfma(v1, pf, o1);
  }
}

DI void load_gate_rows(u32x2 (&gv)[8], const u16* grow0, int lane) {
#pragma unroll
  for (int t = 0; t < 8; ++t) gv[t] = *(const u32x2*)(grow0 + (size_t)((lane >> 4) + 4 * t) * DIN + (lane & 15) * 4);
}
DI void store_y(const f32x16& oa, const f32x16& ob, float mult, const float* sg, const u32x2 (&gv)[8], u16* yrow0, float* stg,
                int lane, int r, int h) {
#pragma unroll
  for (int dt = 0; dt < 2; ++dt)
#pragma unroll
    for (int g = 0; g < 4; ++g) {
      f32x4 v;
      v[0] = (dt ? ob[4 * g] : oa[4 * g]) * mult; v[1] = (dt ? ob[4 * g + 1] : oa[4 * g + 1]) * mult;
      v[2] = (dt ? ob[4 * g + 2] : oa[4 * g + 2]) * mult; v[3] = (dt ? ob[4 * g + 3] : oa[4 * g + 3]) * mult;
      *(f32x4*)(stg + r * 68 + 32 * dt + 8 * g + 4 * h) = v;
    }
  const int kc = lane & 15;
  f32x4 sv = {1.f, 1.f, 1.f, 1.f};
  if (sg) sv = *(const f32x4*)(sg + kc * 4);
#pragma unroll
  for (int t = 0; t < 8; ++t) {
    const int row = (lane >> 4) + 4 * t;
    const f32x4 v = *(const f32x4*)(stg + row * 68 + kc * 4);
    float y0 = v[0] * sv[0] * silu(bflo(gv[t][0]));
    float y1 = v[1] * sv[1] * silu(bfhi(gv[t][0]));
    float y2 = v[2] * sv[2] * silu(bflo(gv[t][1]));
    float y3 = v[3] * sv[3] * silu(bfhi(gv[t][1]));
    u32x2 yo = {pk2(y0, y1), pk2(y2, y3)};
    *(u32x2*)(yrow0 + (size_t)row * DM + kc * 4) = yo;
  }
}

DI void attn_item_A(const Params& p, int layer, int b, int head, int qb, u16* sm, float lam, float lam_init, int wv) {
  const int tid = tid_now(wv), lane = tid & 63, w = tid >> 6, r = lane & 31, h = lane >> 5;
  const int qsub = w & 1, kh = w >> 1;
  const int q0 = qb * 64, q0w = q0 + 32 * qsub, qpos = q0w + r;
  const int qoff = head * 64, koff = 256 + head * 64, vh = head, goff = 768 + head * 64, yoff = head * 64;
  const u16* projb = p.proj + (size_t)b * SEQ * DIN;
  u16* Kb0 = sm + kh * (4 * 64 * 64);

  bf16x8 qf[4];
#pragma unroll
  for (int ks = 0; ks < 4; ++ks) qf[ks] = *(const bf16x8*)(projb + (size_t)qpos * DIN + qoff + 16 * ks + 8 * h);
  const float sl2 = exp2f(-8.f * (float)(9 + head) / 12.f) * LOG2E;
  int lo[4];
#pragma unroll
  for (int c = 0; c < 4; ++c) lo[c] = r * 64 + (((2 * c + h) ^ ((r >> 1) & 7)) * 8);

  const int t7 = tid & 127, wp = t7 >> 6;
  const int csrc = (lane & 7) ^ ((4 * wp + (lane >> 4)) & 7);
  const int row0 = wp * 8 + (lane >> 3);
  const u16* kg = projb + koff + csrc * 8;
  const u16* vg = p.vt + ((size_t)(b * NVH + vh) * 64) * SEQ + csrc * 8;

  float zf = 0.f;
  asm volatile("" : "+v"(zf));
  f32x16 o[2][2];
#pragma unroll
  for (int a = 0; a < 2; ++a)
#pragma unroll
    for (int d = 0; d < 2; ++d)
#pragma unroll
      for (int e = 0; e < 16; ++e) o[a][d][e] = zf;
  float m0 = 0.f, m1 = 0.f;
  f32x16 ls0, ls1;
#pragma unroll
  for (int e = 0; e < 16; ++e) { ls0[e] = zf; ls1[e] = zf; }
  bool started = false;

  const int npairs = (qb >> 1) + 1;
  const int T0 = 2 * (npairs - 1) + kh;
  const bool v0 = (T0 <= qb);
  auto dma_tile = [&](int T, int c) {
    const int k0 = 64 * T;
    u16* Kd = Kb0 + c * (2 * 64 * 64) + wp * (8 * 64);
#pragma unroll
    for (int i = 0; i < 4; ++i) {
      __builtin_amdgcn_global_load_lds((const unsigned*)(kg + (size_t)(k0 + row0 + 16 * i) * DIN), (unsigned*)(Kd + i * 16 * 64), 16, 0, 0);
      __builtin_amdgcn_global_load_lds((const unsigned*)(vg + (size_t)(row0 + 16 * i) * SEQ + k0), (unsigned*)(Kd + 64 * 64 + i * 16 * 64), 16, 0, 0);
    }
  };
  if (v0) dma_tile(T0, 0);
  asm volatile("" :: "v"(qf[0]), "v"(qf[1]), "v"(qf[2]), "v"(qf[3]));
  asm volatile("s_waitcnt vmcnt(0)" ::: "memory");
  __syncthreads();
  for (int j = 0; j < npairs; ++j) {
    if (j + 1 < npairs) dma_tile(T0 - 2 * (j + 1), (j + 1) & 1);
    if (j > 0 || v0) {
      const int T = T0 - 2 * j;
      const u16* Ks = Kb0 + (j & 1) * (2 * 64 * 64);
      const u16* Vs = Ks + 64 * 64;
      const int k0 = 64 * T;
      const bool need_mask = (T == qb);
      const int dl = qpos - k0 - 4 * h;
      diff_softmax_pv(qf, Ks, Vs, m0, ls0, ls1, o, sl2, dl, need_mask, !started, r, h, 64, lo);
      m1 = m0;
      started = true;
    }
    asm volatile("s_waitcnt vmcnt(0)" ::: "memory");
    __syncthreads();
  }

  if (!started) { m0 = -INFINITY; m1 = -INFINITY; }
  float l0 = ls0[0], l1 = ls1[0];
  u32x2 gate[8];
  if (kh == 0) load_gate_rows(gate, projb + (size_t)q0w * DIN + goff, lane);
  float* cb = (float*)sm + (size_t)qsub * 68 * 64 + lane;
  if (kh == 1) {
#pragma unroll
    for (int a = 0; a < 2; ++a)
#pragma unroll
      for (int d = 0; d < 2; ++d)
#pragma unroll
        for (int e = 0; e < 16; ++e) cb[((a * 2 + d) * 16 + e) * 64] = o[a][d][e];
    cb[64 * 64] = m0; cb[65 * 64] = l0; cb[66 * 64] = m1; cb[67 * 64] = l1;
  }
  __syncthreads();
  if (kh == 0) {
    {
      const float mb = cb[64 * 64], lb = cb[65 * 64];
      const float mn = fmaxf(m0, mb), fa = ex2(m0 - mn), fb = ex2(mb - mn);
      l0 = l0 * fa + lb * fb;
#pragma unroll
      for (int d = 0; d < 2; ++d)
#pragma unroll
        for (int e = 0; e < 16; ++e) o[0][d][e] = o[0][d][e] * fa + cb[((0 * 2 + d) * 16 + e) * 64] * fb;
    }
    {
      const float mb = cb[66 * 64], lb = cb[67 * 64];
      const float mn = fmaxf(m1, mb), fa = ex2(m1 - mn), fb = ex2(mb - mn);
      l1 = l1 * fa + lb * fb;
#pragma unroll
      for (int d = 0; d < 2; ++d)
#pragma unroll
        for (int e = 0; e < 16; ++e) o[1][d][e] = o[1][d][e] * fa + cb[((1 * 2 + d) * 16 + e) * 64] * fb;
    }
    const float inv0 = 1.f / l0, inv1 = lam / l1;
    float sq = 0.f;
#pragma unroll
    for (int dt = 0; dt < 2; ++dt)
#pragma unroll
      for (int e = 0; e < 16; ++e) {
        float v = o[0][dt][e] * inv0 - o[1][dt][e] * inv1;
        o[0][dt][e] = v;
        sq += v * v;
      }
    sq += shx(sq, lane);
    const float mult = __builtin_amdgcn_rsqf(sq * (1.f / 64.f) + EPS) * (1.f - lam_init);
    store_y(o[0][0], o[0][1], mult, p.subln_g + layer * 64, gate,
            p.y + ((size_t)b * SEQ + q0w) * DM + yoff, (float*)sm + 9216 + w * 2176, lane, r, h);
  }
}

template <int MODE>
DI void attn_item(const Params& p, int layer, int b, int head, int qblk, u16* sm, volatile LAS int* s_done_, int wv) {
  const int tid = tid_now(wv), lane = tid & 63, w = tid >> 6, r = lane & 31, h = lane >> 5;
  const int q0 = qblk * 128, q0w = q0 + 32 * w, qpos = q0w + r;
  int qoff, koff, vh, goff, yoff;
  if (MODE == 1) { qoff = 1024 + head * 64; koff = 1536 + (head >> 2) * 64; vh = 4 + (head >> 2); goff = 1792 + head * 64; yoff = 256 + head * 64; }
  else { qoff = 2304 + head * 64; koff = 2560 + head * 64; vh = 6 + head; goff = 3072 + head * 64; yoff = 768 + head * 64; }
  const u16* projb = p.proj + (size_t)b * SEQ * DIN;
  u16* Ks = sm;
  u16* Vs = sm + 64 * LSTR;

  bf16x8 qf[4];
#pragma unroll
  for (int ks = 0; ks < 4; ++ks) qf[ks] = *(const bf16x8*)(projb + (size_t)qpos * DIN + qoff + 16 * ks + 8 * h);

  float sl2 = 0.f;
  if (MODE == 1) sl2 = exp2f(-8.f * (float)(1 + head) / 12.f) * LOG2E;
  int lo[4];
#pragma unroll
  for (int c = 0; c < 4; ++c) lo[c] = r * LSTR + c * 16 + 8 * h;

  int it0 = 0, ntiles;
  if (MODE == 1) { ntiles = 4; it0 = (qblk == 0) ? 2 : 0; }
  else ntiles = 2 * (qblk + 1);

  const u16* kg = projb + koff + (tid & 7) * 8;
  const u16* vg = p.vt + ((size_t)(b * NVH + vh) * 64) * SEQ + (tid & 7) * 8;
  const int row0 = tid >> 3;
  const int loff = row0 * LSTR + (tid & 7) * 8;

  f32x16 o[2];
#pragma unroll
  for (int d = 0; d < 2; ++d)
#pragma unroll
    for (int e = 0; e < 16; ++e) o[d][e] = 0.f;
  float m0 = -INFINITY, R = 0.f;
  f32x16 ls0;
#pragma unroll
  for (int e = 0; e < 16; ++e) ls0[e] = (MODE == 1) ? 1.f : 0.f;
  if (MODE == 1) m0 = p.sinks[layer * 8 + head] * LOG2E;
  int wdone = 0;
  volatile LAS int* s_done = lds_fresh(s_done_);
  if (MODE == 2 && lane == 0) s_done[w] = 0;

  auto tile_k0 = [&](int it) -> int {
    if (MODE == 1) return q0 - 128 + 64 * it;
    return 64 * (ntiles - 1 - it);
  };
  u32x2 gate[8];
  load_gate_rows(gate, projb + (size_t)q0w * DIN + goff, lane);
  bool stop = false;
  for (int base = 0; base < ntiles && !stop; base += 4) {
    u32x4 rk[4][2], rv[4][2];
#pragma unroll
    for (int c = 0; c < 4; ++c) {
      const int it = base + c;
      if (it >= it0 && it < ntiles) {
        const int k0 = tile_k0(it);
#pragma unroll
        for (int i = 0; i < 2; ++i) {
          rk[c][i] = *(const u32x4*)(kg + (size_t)(k0 + row0 + 32 * i) * DIN);
          rv[c][i] = *(const u32x4*)(vg + (size_t)(row0 + 32 * i) * SEQ + k0);
        }
      }
    }
    __syncthreads();
    if (MODE == 2 && base > 0 && (s_done[0] & s_done[1] & s_done[2] & s_done[3])) { stop = true; }
    if (!stop) {
#pragma unroll
      for (int c = 0; c < 4; ++c) {
        const int it = base + c;
        if (it >= it0 && it < ntiles) {
#pragma unroll
          for (int i = 0; i < 2; ++i) {
            *(u32x4*)(Ks + c * (2 * 64 * LSTR) + loff + i * 32 * LSTR) = rk[c][i];
            *(u32x4*)(Vs + c * (2 * 64 * LSTR) + loff + i * 32 * LSTR) = rv[c][i];
          }
        }
      }
    }
    __syncthreads();
    if (!stop) {
#pragma unroll
      for (int c = 0; c < 4; ++c) {
        const int it = base + c;
        if (it >= it0 && it < ntiles) {
          const u16* Kc = Ks + c * (2 * 64 * LSTR);
          const u16* Vc = Vs + c * (2 * 64 * LSTR);
          const int k0 = tile_k0(it);
          bool skip, need_mask;
          if (MODE == 1) { skip = (k0 > q0w + 31) || (k0 + 63 < q0w - 127); need_mask = true; }
          else { skip = (k0 >= q0w + 31) || wdone; need_mask = (k0 + 63 >= q0w); }
          if (!skip) {
            const int dl = qpos - k0 - 4 * h;
            if (MODE == 1) {
              softmax_pv<1, 0, 4>(qf, Kc, Vc, m0, ls0, o[0], o[1], sl2, dl, need_mask, false, r, h, LSTR, lo);
            } else {
              f32x16 sa[2];
#pragma unroll
              for (int e = 0; e < 16; ++e) { sa[0][e] = 0.f; sa[1][e] = 0.f; }
#pragma unroll
              for (int t = 0; t < 2; ++t)
#pragma unroll
                for (int ks = 0; ks < 4; ++ks) {
                  bf16x8 kf = ldsv(Kc + (32 * t + r) * LSTR + ks * 16 + 8 * h);
                  sa[t] = mfma(kf, qf[ks], sa[t]);
                }
              stick_pv(sa[0], sa[1], R, o[0], o[1], Vc, dl, need_mask, r, h);
              wdone = __all(R < -160.f) ? 1 : 0;
            }
          }
        }
      }
      if (MODE == 2 && lane == 0) s_done[w] = wdone;
    }
  }
  __syncthreads();

  float inv = 1.f;
  if (MODE == 1) inv = 1.f / ls0[0];
  store_y(o[0], o[1], inv, nullptr, gate, p.y + ((size_t)b * SEQ + q0w) * DM + yoff,
          (float*)sm + 9216 + w * 2176, lane, r, h);
}

DI void attn_item_B2(const Params& p, int layer, int b, int head0, int qblk, u16* sm, int wv) {
  asm volatile("" : "+s"(head0));
  const int tid = tid_now(wv), lane = tid & 63, w = tid >> 6, r = lane & 31, h = lane >> 5;
  const int q0 = qblk * 128, q0w = q0 + 32 * w, qpos = q0w + r;
  const int koff = 1536 + (head0 >> 2) * 64, vh = 4 + (head0 >> 2);
  const u16* projb = p.proj + (size_t)b * SEQ * DIN;
  u16* Ks = sm;
  u16* Vs = sm + 64 * LSTR;
  const int it0 = (qblk == 0) ? 2 : 0;

  bf16x8 qf[2][4];
  u32x2 gate[2][8];
#pragma unroll
  for (int hh = 0; hh < 2; ++hh) {
#pragma unroll
    for (int ks = 0; ks < 4; ++ks)
      qf[hh][ks] = *(const bf16x8*)(projb + (size_t)qpos * DIN + 1024 + (head0 + hh) * 64 + 16 * ks + 8 * h);
    load_gate_rows(gate[hh], projb + (size_t)q0w * DIN + 1792 + (head0 + hh) * 64, lane);
  }
  int lo[4];
#pragma unroll
  for (int c = 0; c < 4; ++c) lo[c] = r * LSTR + c * 16 + 8 * h;

  const u16* kg = projb + koff + (tid & 7) * 8;
  const u16* vg = p.vt + ((size_t)(b * NVH + vh) * 64) * SEQ + (tid & 7) * 8;
  const int row0 = tid >> 3;
  const int loff = row0 * LSTR + (tid & 7) * 8;
  {
    u32x4 rk[4][2], rv[4][2];
#pragma unroll
    for (int c = 0; c < 4; ++c) {
      if (c >= it0) {
        const int k0 = q0 - 128 + 64 * c;
#pragma unroll
        for (int i = 0; i < 2; ++i) {
          rk[c][i] = *(const u32x4*)(kg + (size_t)(k0 + row0 + 32 * i) * DIN);
          rv[c][i] = *(const u32x4*)(vg + (size_t)(row0 + 32 * i) * SEQ + k0);
        }
      }
    }
    __syncthreads();
#pragma unroll
    for (int c = 0; c < 4; ++c) {
      if (c >= it0) {
#pragma unroll
        for (int i = 0; i < 2; ++i) {
          *(u32x4*)(Ks + c * (2 * 64 * LSTR) + loff + i * 32 * LSTR) = rk[c][i];
          *(u32x4*)(Vs + c * (2 * 64 * LSTR) + loff + i * 32 * LSTR) = rv[c][i];
        }
      }
    }
    __syncthreads();
  }
  float zf = 0.f, onef = 1.f;
  asm volatile("" : "+v"(zf), "+v"(onef));
  f32x16 o[2][2], ls[2];
  float mref[2];
#pragma unroll
  for (int hh = 0; hh < 2; ++hh) {
    const int head = head0 + hh;
    const float sl2 = exp2f(-8.f * (float)(1 + head) / 12.f) * LOG2E;
#pragma unroll
    for (int e = 0; e < 16; ++e) { o[hh][0][e] = zf; o[hh][1][e] = zf; ls[hh][e] = onef; }
    mref[hh] = p.sinks[layer * 8 + head] * LOG2E;
#pragma unroll
    for (int c = 0; c < 4; ++c) {
      if (c >= it0) {
        const int k0 = q0 - 128 + 64 * c;
        const bool skip = (k0 > q0w + 31) || (k0 + 63 < q0w - 127);
        if (!skip) {
          const int dl = qpos - k0 - 4 * h;
          softmax_pv<1, 0, 4>(qf[hh], Ks + c * (2 * 64 * LSTR), Vs + c * (2 * 64 * LSTR), mref[hh], ls[hh], o[hh][0], o[hh][1],
                              sl2, dl, true, false, r, h, LSTR, lo);
        }
      }
    }
  }
  __syncthreads();
#pragma unroll
  for (int hh = 0; hh < 2; ++hh)
    store_y(o[hh][0], o[hh][1], 1.f / ls[hh][0], nullptr, gate[hh], p.y + ((size_t)b * SEQ + q0w) * DM + 256 + (head0 + hh) * 64,
            (float*)sm + 9216 + w * 2176, lane, r, h);
}

__global__ void __launch_bounds__(256, 2) hymba_mega(Params p) {
  cg::grid_group grid = cg::this_grid();
  __shared__ __attribute__((aligned(16))) u16 sm[SMEM_U16];
  __shared__ int s_item;
  __shared__ int s_done[4];
  const int wv = __builtin_amdgcn_readfirstlane((int)threadIdx.x >> 6);
  const int bid = blockIdx.x, nb = gridDim.x;
  const int xcd = bid & 7, lb = bid >> 3, nxb = nb >> 3;
  __shared__ __attribute__((aligned(16))) unsigned xb_words[4];
  if (tid_now(wv) == 0) { xb_words[0] = 0u; xb_words[1] = 0u; xb_words[2] = 0u; xb_words[3] = 0u; }
  __syncthreads();
  const XcdBarrier gb = xcd_barrier_post(p.bar, (volatile LAS unsigned*)xb_words, wv);
  if (p.never) grid.sync();

  for (int rep = 0; rep < REP_PREP; ++rep) { phase_prep(p, sm, wv); xcd_barrier(gb); }

  for (int layer = 0; layer < DEPTH; ++layer) {
    for (int rep = 0; rep < REP_G0; ++rep) {
      for (int u = lb; u < 8 * 26; u += nxb) gemm_tile<0>(p, layer, xcd + 8 * (u & 7), u >> 3, sm, wv);
      xcd_barrier(gb);
    }

    {
      const float lam_init = 0.8f - 0.6f * expf(-0.3f * (float)layer);
      float d1 = 0.f, d2 = 0.f;
      for (int i = 0; i < 32; ++i) {
        d1 += p.lq1[layer * 32 + i] * p.lk1[layer * 32 + i];
        d2 += p.lq2[layer * 32 + i] * p.lk2[layer * 32 + i];
      }
      const float lam = expf(d1) - expf(d2) + lam_init;
      for (int rep = 0; rep < REP_ATT; ++rep) {
      if (rep) xcd_barrier(gb);
      unsigned* qctr = p.ctr + (rep * 2 + layer) * 8 + xcd;
      for (;;) {
        __syncthreads();
        volatile LAS int* sit = lds_fresh((volatile LAS int*)&s_item);
        if (tid_now(wv) == 0) *sit = (int)atomicAdd(qctr, 1u);
        __syncthreads();
        const int item = *sit;
        if (item >= N_ITEMS_XCD) break;
        const int slot = (item < 128) ? 0 : (item < 192) ? 1 : 3, per = (item < 128) ? 0 : (item < 192) ? item - 128 : item - 192;
        if (slot == 0 || slot == 2) {
          const int ia = item;
          if (!(rep && (0 < REP_LO || 128 > REP_HI)))
          attn_item_A(p, layer, xcd >> 2, xcd & 3, 127 - ia, sm, lam, lam_init, wv);
        } else if (slot == 1) {
          if (!(rep && (128 < REP_LO || 192 > REP_HI)))
          attn_item_B2(p, layer, (2 * xcd) >> 3, (2 * xcd) & 7, 63 - per, sm, wv);
        } else {
          if (!(rep && (192 < REP_LO || 256 > REP_HI)))
          attn_item<2>(p, layer, xcd >> 2, xcd & 3, 63 - per, sm, (volatile LAS int*)s_done, wv);
        }
      }
      }
    }
    xcd_barrier(gb);

    for (int u = lb; u < 8 * 8; u += nxb) gemm_tile<1>(p, layer, xcd + 8 * (u & 7), u >> 3, sm, wv);
    xcd_barrier(gb);
  }

  {
    const int tid = tid_now(wv), lane = tid & 63;
    const float* ssf = p.ss + (size_t)DEPTH * MTOK;
    f32x4 gv[4];
#pragma unroll
    for (int j = 0; j < 4; ++j) gv[j] = *(const f32x4*)(p.final_g + j * 256 + lane * 4);
    for (int row0 = (bid * 4 + (tid >> 6)) * 4; row0 < MTOK; row0 += nb * 16) {
      f32x4 xv[4][4];
      float rs[4];
#pragma unroll
      for (int q = 0; q < 4; ++q) {
        rs[q] = ssf[row0 + q];
#pragma unroll
        for (int j = 0; j < 4; ++j) {
          const u32x2 xb = *(const u32x2*)((const u16*)p.x2 + (size_t)(row0 + q) * DM + j * 256 + lane * 4);
          xv[q][j][0] = bflo(xb[0]); xv[q][j][1] = bfhi(xb[0]); xv[q][j][2] = bflo(xb[1]); xv[q][j][3] = bfhi(xb[1]);
        }
      }
#pragma unroll
      for (int q = 0; q < 4; ++q) {
        const float rq = __builtin_amdgcn_rsqf(rs[q] * (1.f / DM) + EPS);
#pragma unroll
        for (int j = 0; j < 4; ++j) {
          f32x4 v = xv[q][j];
          v[0] *= rq * gv[j][0]; v[1] *= rq * gv[j][1]; v[2] *= rq * gv[j][2]; v[3] *= rq * gv[j][3];
          *(f32x4*)(p.out + (size_t)(row0 + q) * DM + j * 256 + lane * 4) = v;
        }
      }
    }
  }
}

extern "C" void kernel_launch(void* const* d_in, const int* in_sizes, int n_in, void* d_out, int out_size, void* d_ws,
                              size_t ws_size, hipStream_t stream) {
  static int grid_blocks = 0;
  if (!grid_blocks) {
    int dev = 0, cus = 0, per_cu = 0;
    hipGetDevice(&dev);
    hipDeviceGetAttribute(&cus, hipDeviceAttributeMultiprocessorCount, dev);
    hipOccupancyMaxActiveBlocksPerMultiprocessor(&per_cu, hymba_mega, 256, 0);
    if (per_cu > 2) per_cu = 2;
    if (per_cu < 1) per_cu = 1;
    grid_blocks = cus * per_cu;
    grid_blocks -= grid_blocks % 8;
  }
  Params p{};
  p.x = (const float*)d_in[0]; p.norm_g = (const float*)d_in[1]; p.w_in = (const float*)d_in[2];
  p.lq1 = (const float*)d_in[3]; p.lk1 = (const float*)d_in[4]; p.lq2 = (const float*)d_in[5];
  p.lk2 = (const float*)d_in[6]; p.subln_g = (const float*)d_in[7]; p.sinks = (const float*)d_in[8];
  p.w_out = (const float*)d_in[9]; p.final_g = (const float*)d_in[10];
  p.out = (float*)d_out;
  char* ws = (char*)d_ws;
  size_t off = 0;
  auto take = [&](size_t bytes) { char* q = ws + off; off += (bytes + 255) & ~(size_t)255; return q; };
  p.wtin = (u16*)take((size_t)DEPTH * DIN * 1024 * 2);
  p.wtout = (u16*)take((size_t)DEPTH * 1024 * 1024 * 2);
  p.xg = (u16*)take((size_t)MTOK * DM * 2);
  p.proj = (u16*)take((size_t)MTOK * DIN * 2);
  p.vt = (u16*)take((size_t)NBATCH * NVH * 64 * SEQ * 2);
  p.y = (u16*)take((size_t)MTOK * DM * 2);
  p.ss = (float*)take((size_t)3 * MTOK * 4);
  p.ctr = (unsigned*)take(256);
  p.bar = (unsigned*)take((size_t)XCD_BAR_WORDS * 4);
  p.x2 = (float*)p.proj;
  p.never = 0;
  (void)hipMemsetAsync(p.bar, 0, (size_t)XCD_BAR_WORDS * 4, stream);
  void* args[] = {&p};
  hipError_t e = hipLaunchCooperativeKernel((void*)hymba_mega, dim3(grid_blocks), dim3(256), args, 0, stream);
  if (e != hipSuccess) fprintf(stderr, "cooperative launch failed: %s (grid %d)\n", hipGetErrorString(e), grid_blocks);
}
```

```cpp
#include <hip/hip_runtime.h>
#include <hip/hip_cooperative_groups.h>
#include <cstdio>
namespace cg = cooperative_groups;

#define DI __device__ __forceinline__
#define LAS __attribute__((address_space(3)))
typedef unsigned short u16;
typedef __attribute__((ext_vector_type(8))) __bf16 bf16x8;
typedef __attribute__((ext_vector_type(2))) __bf16 bf16x2;
typedef __attribute__((ext_vector_type(16))) float f32x16;
typedef __attribute__((ext_vector_type(2))) float f32x2;
typedef __attribute__((ext_vector_type(4))) unsigned u32x4;
typedef __attribute__((ext_vector_type(2))) unsigned u32x2;
typedef __attribute__((ext_vector_type(4))) float f32x4;

constexpr int SEQ = 8192, NBATCH = 2, DM = 1024, MTOK = NBATCH * SEQ, DIN = 3328, DEPTH = 2, NVH = 10;
constexpr float EPS = 1e-5f, LOG2E = 1.4426950408889634f;
constexpr int LSTR = 72;
constexpr int SMEM_U16 = 8 * 64 * LSTR;
constexpr int N_ITEMS_XCD = 128 + 64 + 64;
#ifndef REP_PREP
#define REP_PREP 1
#endif
#ifndef REP_G0
#define REP_G0 1
#endif
#ifndef REP_ATT
#define REP_ATT 1
#endif
#ifndef REP_LO
#define REP_LO 0
#endif
#ifndef REP_HI
#define REP_HI N_ITEMS_XCD
#endif

struct Params {
  const float *x, *norm_g, *w_in, *lq1, *lk1, *lq2, *lk2, *subln_g, *sinks, *w_out, *final_g;
  float* out;
  u16* wtin;
  u16* wtout;
  u16* xg;
  u16* proj;
  u16* vt;
  u16* y;
  float* ss;
  unsigned* ctr;
  unsigned* bar;
  float* x2;
  size_t never;
};

DI unsigned pk2(float a, float b) {
  f32x2 v = {a, b};
  bf16x2 r = __builtin_convertvector(v, bf16x2);
  return __builtin_bit_cast(unsigned, r);
}
DI uint2 pk4(float a, float b, float c, float d) { uint2 r; r.x = pk2(a, b); r.y = pk2(c, d); return r; }
DI float bflo(unsigned v) { return __uint_as_float(v << 16); }
DI float bfhi(unsigned v) { return __uint_as_float(v & 0xffff0000u); }
DI float ex2(float x) { return __builtin_amdgcn_exp2f(x); }

DI float lg2(float x) { return __builtin_amdgcn_logf(x); }
DI f32x16 mfma(bf16x8 a, bf16x8 b, f32x16 c) { return __builtin_amdgcn_mfma_f32_32x32x16_bf16(a, b, c, 0, 0, 0); }
DI bf16x8 ldsv(const u16* p) { return *(const bf16x8*)p; }
DI float silu(float g) { return g * __builtin_amdgcn_rcpf(1.f + ex2(-g * LOG2E)); }
DI int tid_now(int wv) {
  int t;
  asm volatile("v_mbcnt_lo_u32_b32 %0, -1, 0\n\tv_mbcnt_hi_u32_b32 %0, -1, %0" : "=v"(t));
  return wv * 64 + t;
}
DI float shx(float v, int lane, int o = 32) {
  return __int_as_float(__builtin_amdgcn_ds_bpermute((lane ^ o) << 2, __float_as_int(v)));
}
template <typename T> DI volatile LAS T* lds_fresh(volatile LAS T* q) { asm volatile("" : "+v"(q)); return q; }
DI float wave_sum(float v, int lane) {
#pragma unroll
  for (int o = 32; o >= 1; o >>= 1) v += shx(v, lane, o);
  return v;
}


#define XB_TMO      128
#define XB_XCNT(j)  (256  + 64 * (j))
#define XB_XSUB(j)  (1280 + 64 * (j))
#define XB_XGEN(j)  (2304 + 64 * (j))
#define XB_TOP      3328
#define XB_TOPGEN   3392
#define XCD_BAR_WORDS 3456
#define XB_SPIN_CAP (1u << 18)
DI unsigned xb_ld(unsigned* p) { return __hip_atomic_load(p, __ATOMIC_RELAXED, __HIP_MEMORY_SCOPE_AGENT); }
DI unsigned xb_add(unsigned* p, unsigned v) { return __hip_atomic_fetch_add(p, v, __ATOMIC_RELAXED, __HIP_MEMORY_SCOPE_AGENT); }
DI unsigned xb_xcc_id() { return (unsigned)__builtin_amdgcn_s_getreg((3 << 11) | 20) & 0xFu; }
#define XB_SPIN(cond, bar) do { unsigned _sp = 0; while (cond) { __builtin_amdgcn_s_sleep(1); \
    if ((++_sp & 255u) == 0u) { if (xb_ld(&(bar)[XB_TMO])) break; if (_sp > XB_SPIN_CAP) { atomicAdd(&(bar)[XB_TMO], 1u); break; } } } } while (0)
struct XcdBarrier { unsigned* bar; unsigned x; volatile LAS unsigned* st; int wv; };
DI XcdBarrier xcd_barrier_post(unsigned* bar, volatile LAS unsigned* st, int wv) {
  XcdBarrier b; b.bar = bar; b.x = xb_xcc_id(); b.st = st; b.wv = wv;
  if (tid_now(wv) == 0) (void)xb_add(&bar[XB_XCNT(b.x)], 1u);
  return b;
}
DI void xcd_barrier_complete(unsigned* bar, unsigned x, unsigned& nloc, unsigned& nx) {
  const unsigned G = gridDim.x * gridDim.y * gridDim.z;
  unsigned sum, cnt, mine, sp = 0u;
  for (;;) {
    sum = 0u; cnt = 0u; mine = 0u;
#pragma unroll
    for (unsigned j = 0; j < 16; ++j) { const unsigned c = xb_ld(&bar[XB_XCNT(j)]); sum += c; cnt += (c > 0u) ? 1u : 0u; mine = (j == x) ? c : mine; }
    if (sum == G) break;
    __builtin_amdgcn_s_sleep(1);
    if ((++sp & 255u) == 0u) { if (xb_ld(&bar[XB_TMO])) break; if (sp > XB_SPIN_CAP) { atomicAdd(&bar[XB_TMO], 1u); break; } }
  }
  nloc = mine > 0u ? mine : 1u; nx = cnt > 0u ? cnt : 1u;
}
DI void xcd_barrier(const XcdBarrier& b) {
  asm volatile("s_waitcnt vmcnt(0)" ::: "memory");
  __syncthreads();
  if (tid_now(b.wv) == 0) {
    unsigned* bar = b.bar;
    __builtin_amdgcn_s_waitcnt(0);
    volatile LAS unsigned* st = lds_fresh(b.st);
    unsigned nloc = st[0], nx = st[1];
    if (nloc == 0u) { xcd_barrier_complete(bar, b.x, nloc, nx); st[0] = nloc; st[1] = nx; }
    const unsigned old = xb_add(&bar[XB_XSUB(b.x)], 1u);
    const unsigned gen = old / nloc;
    if (old + 1u == (gen + 1u) * nloc) {
      __builtin_amdgcn_fence(__ATOMIC_RELEASE, "agent");
      asm volatile("s_waitcnt vmcnt(0)" ::: "memory");
      const unsigned og = xb_add(&bar[XB_TOP], 1u);
      const unsigned tg = og / nx;
      if (og + 1u == (tg + 1u) * nx) xb_add(&bar[XB_TOPGEN], 1u);
      else XB_SPIN(xb_ld(&bar[XB_TOPGEN]) == tg, bar);
      __builtin_amdgcn_fence(__ATOMIC_ACQUIRE, "agent");
      xb_add(&bar[XB_XGEN(b.x)], 1u);
      asm volatile("s_waitcnt vmcnt(0)" ::: "memory");
    } else {
      XB_SPIN(xb_ld(&bar[XB_XGEN(b.x)]) == gen, bar);
      __builtin_amdgcn_fence(__ATOMIC_ACQUIRE, "agent");
      asm volatile("s_waitcnt vmcnt(0)" ::: "memory");
    }
  }
  __syncthreads();
}

DI void phase_prep(const Params& p, u16* sm, int wv) {
  const int tid = tid_now(wv), nb = gridDim.x, bid = blockIdx.x;
  float* smf = (float*)sm;
  constexpr int T_IN = DEPTH * 16 * 52, T_OUT = DEPTH * 16 * 16;
  for (int t = bid; t < T_IN + T_OUT; t += nb) {
    const float* src; u16* dst; int N, kt, nt; const float* gsc = nullptr;
    if (t < T_IN) {
      int l = t / 832, rr = t % 832; kt = rr / 52; nt = rr % 52; N = DIN;
      src = p.w_in + (size_t)l * 1024 * DIN; dst = p.wtin + (size_t)l * DIN * 1024; gsc = p.norm_g + l * DM;
    } else {
      int u = t - T_IN; int l = u / 256, rr = u % 256; kt = rr / 16; nt = rr % 16; N = 1024;
      src = p.w_out + (size_t)l * 1024 * 1024; dst = p.wtout + (size_t)l * 1024 * 1024;
    }
    __syncthreads();
#pragma unroll
    for (int i = 0; i < 4; ++i) {
      const int k = i * 16 + (tid >> 4), n4 = (tid & 15) * 4;
      const f32x4 v = *(const f32x4*)(src + (size_t)(kt * 64 + k) * N + nt * 64 + n4);
      const float gk = gsc ? gsc[kt * 64 + k] : 1.f;
      smf[(n4 + 0) * 65 + k] = v[0] * gk; smf[(n4 + 1) * 65 + k] = v[1] * gk;
      smf[(n4 + 2) * 65 + k] = v[2] * gk; smf[(n4 + 3) * 65 + k] = v[3] * gk;
    }
    __syncthreads();
#pragma unroll
    for (int j = 0; j < 2; ++j) {
      const int c = tid + 256 * j, kc = c & 7, n = c >> 3;
      const float* q = smf + n * 65 + kc * 8;
      u32x4 o = {pk2(q[0], q[1]), pk2(q[2], q[3]), pk2(q[4], q[5]), pk2(q[6], q[7])};
      *(u32x4*)(dst + (size_t)(nt * 64 + n) * 1024 + kt * 64 + kc * 8) = o;
    }
  }
  const int lane = tid & 63;
  {
    for (int row0 = (bid * 4 + (tid >> 6)) * 4; row0 < MTOK; row0 += nb * 16) {
      f32x4 xv[4][4];
#pragma unroll
      for (int q = 0; q < 4; ++q)
#pragma unroll
        for (int j = 0; j < 4; ++j) xv[q][j] = *(const f32x4*)(p.x + (size_t)(row0 + q) * DM + j * 256 + lane * 4);
#pragma unroll
      for (int q = 0; q < 4; ++q) {
        float sq = 0.f;
#pragma unroll
        for (int j = 0; j < 4; ++j) {
          const f32x4 v = xv[q][j];
          sq += v[0] * v[0] + v[1] * v[1] + v[2] * v[2] + v[3] * v[3];
          u32x2 o = {pk2(v[0], v[1]), pk2(v[2], v[3])};
          *(u32x2*)(p.xg + (size_t)(row0 + q) * DM + j * 256 + lane * 4) = o;
        }
        sq = wave_sum(sq, lane);
        if (lane == 0) p.ss[row0 + q] = sq;
      }
    }
  }
  for (int i = bid * 256 + tid; i < 2 * MTOK; i += nb * 256) p.ss[MTOK + i] = 0.f;
  if (bid == 0 && tid < 64) p.ctr[tid] = 0u;
}

constexpr int GSTR = 80;
DI f32x4 mfma16(bf16x8 a, bf16x8 b, f32x4 c) { return __builtin_amdgcn_mfma_f32_16x16x32_bf16(a, b, c, 0, 0, 0); }

template <bool VT>
DI void gemm_kslab(f32x4 (&acc)[8][4], const u16* sA, const u16* sB, int wm, int wn, int fr, int fq) {
#pragma unroll
  for (int ks = 0; ks < 2; ++ks) {
    bf16x8 tb[4], ta[8];
#pragma unroll
    for (int j = 0; j < 4; ++j) tb[j] = ldsv(sB + (wn * 64 + 16 * j + fr) * GSTR + ks * 32 + 8 * fq);
#pragma unroll
    for (int i = 0; i < 8; ++i) ta[i] = ldsv(sA + (wm * 128 + 16 * i + fr) * GSTR + ks * 32 + 8 * fq);
#pragma unroll
    for (int i = 0; i < 8; ++i)
#pragma unroll
      for (int j = 0; j < 4; ++j)
        acc[i][j] = VT ? mfma16(ta[i], tb[j], acc[i][j]) : mfma16(tb[j], ta[i], acc[i][j]);
  }
  __builtin_amdgcn_sched_group_barrier(0x100, 6, 0);
#pragma unroll
  for (int g = 0; g < 6; ++g) {
    __builtin_amdgcn_sched_group_barrier(0x008, 4, 0);
    __builtin_amdgcn_sched_group_barrier(0x100, 1, 0);
  }
  __builtin_amdgcn_sched_group_barrier(0x100, 6, 0);
  __builtin_amdgcn_sched_group_barrier(0x008, 8, 0);
#pragma unroll
  for (int g = 0; g < 6; ++g) {
    __builtin_amdgcn_sched_group_barrier(0x008, 4, 0);
    __builtin_amdgcn_sched_group_barrier(0x100, 1, 0);
  }
  __builtin_amdgcn_sched_group_barrier(0x008, 8, 0);
}

template <bool VT>
DI void gemm_mainloop(f32x4 (&acc)[8][4], const char* abase, const char* bbase, unsigned toff, u16* sA, u16* sB, int loff, int wm, int wn, int fr, int fq) {
  const __amdgpu_buffer_rsrc_t ra_rs = __builtin_amdgcn_make_buffer_rsrc((void*)abase, (short)0, 256 * 2048, 0x00020000);
  const __amdgpu_buffer_rsrc_t rb_rs = __builtin_amdgcn_make_buffer_rsrc((void*)bbase, (short)0, 128 * 2048, 0x00020000);
  u32x4 ra[8], rb[4];
#pragma unroll
  for (int i = 0; i < 8; ++i) ra[i] = __builtin_amdgcn_raw_buffer_load_b128(ra_rs, (int)toff, i * 65536, 0);
#pragma unroll
  for (int i = 0; i < 4; ++i) rb[i] = __builtin_amdgcn_raw_buffer_load_b128(rb_rs, (int)toff, i * 65536, 0);
#pragma unroll 1
  for (int kt = 0; kt < 16; ++kt) {
    __syncthreads();
#pragma unroll
    for (int i = 0; i < 8; ++i) *(u32x4*)(sA + loff + i * 32 * GSTR) = ra[i];
#pragma unroll
    for (int i = 0; i < 4; ++i) *(u32x4*)(sB + loff + i * 32 * GSTR) = rb[i];
    __syncthreads();
    if (kt + 1 < 16) {
      const int ko = (kt + 1) * 128;
#pragma unroll
      for (int i = 0; i < 8; ++i) ra[i] = __builtin_amdgcn_raw_buffer_load_b128(ra_rs, (int)toff, i * 65536 + ko, 0);
#pragma unroll
      for (int i = 0; i < 4; ++i) rb[i] = __builtin_amdgcn_raw_buffer_load_b128(rb_rs, (int)toff, i * 65536 + ko, 0);
    }
    gemm_kslab<VT>(acc, sA, sB, wm, wn, fr, fq);
  }
}

template <int EPI>
DI void gemm_tile(const Params& p, int layer, int mt, int nt, u16* sm, int wv) {
  const int tid = tid_now(wv), w = tid >> 6;
  int lane = tid & 63, fr = lane & 15, fq = lane >> 4;
  const u16* A = (EPI == 0) ? p.xg : p.y;
  const u16* Bt = (EPI == 0) ? p.wtin + (size_t)layer * DIN * 1024 : p.wtout + (size_t)layer * 1024 * 1024;
  const int m0 = mt * 256, n0 = nt * 128;
  const char* abase = (const char*)(A + (size_t)m0 * 1024);
  const char* bbase = (const char*)(Bt + (size_t)n0 * 1024);
  const unsigned toff = (unsigned)(tid >> 3) * 2048u + (unsigned)(tid & 7) * 16u;
  const int loff = (tid >> 3) * GSTR + (tid & 7) * 8;
  u16* sA = sm;
  u16* sB = sm + 256 * GSTR;
  f32x4 acc[8][4];
#pragma unroll
  for (int i = 0; i < 8; ++i)
#pragma unroll
    for (int j = 0; j < 4; ++j)
#pragma unroll
      for (int e = 0; e < 4; ++e) acc[i][j][e] = 0.f;

  bool vtile = false;
  if (EPI == 0) vtile = (nt == 4 || nt == 5 || nt == 13 || nt == 22 || nt == 23);
  int wm = w >> 1, wn = w & 1;

  if (EPI == 0 && vtile) { asm volatile("; v-tile main loop" ::: "memory"); gemm_mainloop<true>(acc, abase, bbase, toff, sA, sB, loff, wm, wn, fr, fq); }
  else { asm volatile("; main loop" ::: "memory"); gemm_mainloop<false>(acc, abase, bbase, toff, sA, sB, loff, wm, wn, fr, fq); }

  {
    const int t2 = tid_now(wv);
    const int l2 = t2 & 63, w2 = t2 >> 6;
    lane = l2; fr = l2 & 15; fq = l2 >> 4; wm = w2 >> 1; wn = w2 & 1;
  }
  if (EPI == 0) {
    const float* ssl = p.ss + (size_t)layer * MTOK;
    __syncthreads();
    u16* stg = sm + (wm * 2 + wn) * (128 * LSTR);
    if (!vtile) {
      const float qsc = (nt < 2) ? 0.17677669529663687f * LOG2E
                        : ((nt >= 8 && nt < 12) || nt == 18 || nt == 19) ? 0.125f * LOG2E : 1.f;
#pragma unroll
      for (int i = 0; i < 8; ++i) {
        const int m = m0 + wm * 128 + 16 * i + fr;
        const float rs = __builtin_amdgcn_rsqf(ssl[m] * (1.f / DM) + EPS) * qsc;
        u16* d = stg + (16 * i + fr) * LSTR + 4 * fq;
#pragma unroll
        for (int j = 0; j < 4; ++j) {
          u32x2 v = {pk2(acc[i][j][0] * rs, acc[i][j][1] * rs), pk2(acc[i][j][2] * rs, acc[i][j][3] * rs)};
          *(u32x2*)(d + 16 * j) = v;
        }
      }
      u16* gdst = p.proj + (size_t)(m0 + wm * 128) * DIN + n0 + wn * 64;
#pragma unroll
      for (int t = 0; t < 16; ++t) {
        const int c = lane + 64 * t, row = c >> 3, kc = c & 7;
        const u32x4 v = *(const u32x4*)(stg + row * LSTR + kc * 8);
        *(u32x4*)(gdst + (size_t)row * DIN + kc * 8) = v;
      }
    } else {
      const int vbase = (nt == 4) ? 0 : (nt == 5) ? 2 : (nt == 13) ? 4 : (nt == 22) ? 6 : 8;
      const int bb = m0 / SEQ, s0 = m0 % SEQ;
      constexpr int VSTR = 136;
#pragma unroll
      for (int i = 0; i < 8; ++i) {
        float rs[4];
#pragma unroll
        for (int e = 0; e < 4; ++e) rs[e] = __builtin_amdgcn_rsqf(ssl[m0 + wm * 128 + 16 * i + 4 * fq + e] * (1.f / DM) + EPS);
        const int pos = 16 * i + 8 * (fq & 1) + 4 * (fq >> 1);
#pragma unroll
        for (int j = 0; j < 4; ++j) {
          u32x2 v = {pk2(acc[i][j][0] * rs[0], acc[i][j][1] * rs[1]), pk2(acc[i][j][2] * rs[2], acc[i][j][3] * rs[3])};
          *(u32x2*)(stg + (16 * j + fr) * VSTR + pos) = v;
        }
      }
      u16* gdst = p.vt + ((size_t)(bb * NVH + vbase + wn) * 64) * SEQ + s0 + wm * 128;
#pragma unroll
      for (int t = 0; t < 16; ++t) {
        const int c = lane + 64 * t, row = c >> 4, kc = c & 15;
        const u32x4 v = *(const u32x4*)(stg + row * VSTR + kc * 8);
        *(u32x4*)(gdst + (size_t)row * SEQ + kc * 8) = v;
      }
    }
  } else {
    const bool has_next = (layer + 1 < DEPTH);
    float* ssn = p.ss + (size_t)(layer + 1) * MTOK;
    __syncthreads();
    float* stg = (float*)(sm + (wm * 2 + wn) * (128 * LSTR));
    const int kc = lane & 15;
#pragma unroll
    for (int hh = 0; hh < 2; ++hh) {
#pragma unroll
      for (int i2 = 0; i2 < 4; ++i2)
#pragma unroll
        for (int j = 0; j < 4; ++j)
          *(f32x4*)(stg + (16 * i2 + fr) * 68 + 16 * j + 4 * fq) = acc[4 * hh + i2][j];
      const size_t mrow0 = (size_t)(m0 + wm * 128 + 64 * hh);
      u16* xrow = p.xg + mrow0 * DM + n0 + wn * 64 + kc * 4;
      u16* x2row = (u16*)p.x2 + mrow0 * DM + n0 + wn * 64 + kc * 4;
      u32x2 xb[16];
#pragma unroll
      for (int t = 0; t < 16; ++t) xb[t] = *(const u32x2*)(xrow + (size_t)((lane >> 4) + 4 * t) * DM);
#pragma unroll
      for (int t = 0; t < 16; ++t) {
        const int row = (lane >> 4) + 4 * t;
        const f32x4 a4 = *(const f32x4*)(stg + row * 68 + kc * 4);
        const float v0 = bflo(xb[t][0]) + a4[0], v1 = bfhi(xb[t][0]) + a4[1], v2 = bflo(xb[t][1]) + a4[2], v3 = bfhi(xb[t][1]) + a4[3];
        float sq = v0 * v0 + v1 * v1 + v2 * v2 + v3 * v3;
        u32x2 pv = {pk2(v0, v1), pk2(v2, v3)};
        if (has_next) *(u32x2*)(xrow + (size_t)row * DM) = pv;
        else *(u32x2*)(x2row + (size_t)row * DM) = pv;
        sq += shx(sq, lane, 1); sq += shx(sq, lane, 2); sq += shx(sq, lane, 4); sq += shx(sq, lane, 8);
        if (kc == 0) atomicAdd(ssn + mrow0 + row, sq);
      }
    }
  }
}

template <int MODE, int KS0, int NKS>
DI void qk_scores(f32x16& s0, f32x16& s1, const u16* Ks, const bf16x8 (&qf)[4], float sl2, int dl, float mref,
                  bool need_mask, int r, int h, int rs, const int (&lo)[4]) {
  asm volatile("" : "+v"(dl));
  const float nb = -sl2 * (float)dl - mref;
#pragma unroll
  for (int i = 0; i < 16; ++i) {
    const int ci = (i & 3) + 8 * (i >> 2);
    s0[i] = fmaf(sl2, (float)ci, nb);
    s1[i] = fmaf(sl2, (float)(ci + 32), nb);
  }
#pragma unroll
  for (int ks = 0; ks < NKS; ++ks) {
    bf16x8 k0 = ldsv(Ks + lo[KS0 + ks]);
    bf16x8 k1 = ldsv(Ks + 32 * rs + lo[KS0 + ks]);
    s0 = mfma(k0, qf[KS0 + ks], s0);
    s1 = mfma(k1, qf[KS0 + ks], s1);
  }
  if (need_mask) {
#pragma unroll
    for (int i = 0; i < 16; ++i) {
      const int ci = (i & 3) + 8 * (i >> 2);
      bool v0 = (MODE == 0) ? (ci <= dl) : (ci <= dl && ci > dl - 128);
      bool v1 = (MODE == 0) ? (ci + 32 <= dl) : (ci + 32 <= dl && ci + 32 > dl - 128);
      s0[i] = v0 ? s0[i] : -INFINITY;
      s1[i] = v1 ? s1[i] : -INFINITY;
    }
  }
}
template <int MODE, int KS0, int NKS>
DI void softmax_pv(const bf16x8 (&qf)[4], const u16* Ks, const u16* Vs, float& m, f32x16& ls, f32x16& o0, f32x16& o1,
                   float sl2, int dl, bool need_mask, bool first, int r, int h, int rs, const int (&lo)[4]) {
  f32x16 s0, s1;
  qk_scores<MODE, KS0, NKS>(s0, s1, Ks, qf, sl2, dl, m, need_mask, r, h, rs, lo);
  if (__any(first || !(ls[0] <= 1.0e12f))) {
    float tmax = -INFINITY;
#pragma unroll
    for (int i = 0; i < 16; ++i) tmax = fmaxf(tmax, fmaxf(s0[i], s1[i]));
    tmax = fmaxf(tmax, shx(tmax, r + 32 * h));
    const float lref = (ls[0] > 1.f) ? lg2(ls[0]) : 0.f;
    const float delta = first ? tmax : fmaxf(fmaxf(tmax, lref), 0.f);
    m += delta;
    const float alpha = ex2(-delta);
#pragma unroll
    for (int e = 0; e < 16; ++e) { o0[e] *= alpha; o1[e] *= alpha; ls[e] *= alpha; }
#pragma unroll
    for (int i = 0; i < 16; ++i) { s0[i] -= delta; s1[i] -= delta; }
  }
#pragma unroll
  for (int i = 0; i < 16; ++i) { s0[i] = ex2(s0[i]); s1[i] = ex2(s1[i]); }
  const u32x4 one4 = {0x3f803f80u, 0x3f803f80u, 0x3f803f80u, 0x3f803f80u};
  const bf16x8 ones = __builtin_bit_cast(bf16x8, one4);
#pragma unroll
  for (int kk = 0; kk < 4; ++kk) {
    const int s = kk & 1;
    unsigned u0, u1, u2, u3;
    if (kk < 2) {
      u0 = pk2(s0[8 * s], s0[8 * s + 1]); u1 = pk2(s0[8 * s + 2], s0[8 * s + 3]);
      u2 = pk2(s0[8 * s + 4], s0[8 * s + 5]); u3 = pk2(s0[8 * s + 6], s0[8 * s + 7]);
    } else {
      u0 = pk2(s1[8 * s], s1[8 * s + 1]); u1 = pk2(s1[8 * s + 2], s1[8 * s + 3]);
      u2 = pk2(s1[8 * s + 4], s1[8 * s + 5]); u3 = pk2(s1[8 * s + 6], s1[8 * s + 7]);
    }
    u32x4 uu = {u0, u1, u2, u3};
    bf16x8 pf = __builtin_bit_cast(bf16x8, uu);
    bf16x8 v0 = ldsv(Vs + lo[kk]);
    bf16x8 v1 = ldsv(Vs + 32 * rs + lo[kk]);
    o0 = mfma(v0, pf, o0);
    o1 = mfma(v1, pf, o1);
    ls = mfma(ones, pf, ls);
  }
}

DI void pv_frag_step(f32x16& s0, f32x16& s1, const u16* Vs, f32x16& o0, f32x16& o1, f32x4& ls, bf16x8 ones, int rs, const int (&lo)[4]) {
#pragma unroll
  for (int i = 0; i < 16; ++i) { s0[i] = ex2(s0[i]); s1[i] = ex2(s1[i]); }
#pragma unroll
  for (int kk = 0; kk < 4; ++kk) {
    const int s = kk & 1;
    unsigned u0, u1, u2, u3;
    if (kk < 2) {
      u0 = pk2(s0[8 * s], s0[8 * s + 1]); u1 = pk2(s0[8 * s + 2], s0[8 * s + 3]);
      u2 = pk2(s0[8 * s + 4], s0[8 * s + 5]); u3 = pk2(s0[8 * s + 6], s0[8 * s + 7]);
    } else {
      u0 = pk2(s1[8 * s], s1[8 * s + 1]); u1 = pk2(s1[8 * s + 2], s1[8 * s + 3]);
      u2 = pk2(s1[8 * s + 4], s1[8 * s + 5]); u3 = pk2(s1[8 * s + 6], s1[8 * s + 7]);
    }
    u32x4 uu = {u0, u1, u2, u3};
    bf16x8 pf = __builtin_bit_cast(bf16x8, uu);
    bf16x8 v0 = ldsv(Vs + lo[kk]);
    bf16x8 v1 = ldsv(Vs + 32 * rs + lo[kk]);
    o0 = mfma(v0, pf, o0);
    o1 = mfma(v1, pf, o1);
    ls = mfma16(ones, pf, ls);
  }
}
DI void mask_causal(f32x16& s0, f32x16& s1, int dl) {
#pragma unroll
  for (int i = 0; i < 16; ++i) {
    const int ci = (i & 3) + 8 * (i >> 2);
    s0[i] = (ci <= dl) ? s0[i] : -INFINITY;
    s1[i] = (ci + 32 <= dl) ? s1[i] : -INFINITY;
  }
}
DI float bperm(float v, int srclane) { return __int_as_float(__builtin_amdgcn_ds_bpermute(srclane << 2, __float_as_int(v))); }
DI float own_rowsum(const f32x4& ls, int r) {
  const float a = bperm(ls[0], r & 15), b = bperm(ls[1], r & 15);
  return (r >> 4) ? b : a;
}
DI bf16x8 rowsum_ones(int lane) {
  const int fr16 = lane & 15, g = lane >> 4;
  const unsigned w = (fr16 < 2 && fr16 == (g & 1)) ? 0x3f803f80u : 0u;
  const u32x4 v = {w, w, w, w};
  return __builtin_bit_cast(bf16x8, v);
}
DI void diff_softmax_pv(const bf16x8 (&qf)[4], const u16* Ks, const u16* Vs, float& m, f32x4& ls0, f32x4& ls1, bf16x8 ones,
                        f32x16 (&o)[2][2], float sl2, int dl, bool need_mask, bool first, int r, int h, int rs, const int (&lo)[4]) {
  f32x16 b0, b1;
  const float nb = -sl2 * (float)dl - m;
#pragma unroll
  for (int i = 0; i < 16; ++i) {
    const int ci = (i & 3) + 8 * (i >> 2);
    b0[i] = fmaf(sl2, (float)ci, nb);
    b1[i] = fmaf(sl2, (float)(ci + 32), nb);
  }
  {
    f32x16 s0 = mfma(ldsv(Ks + lo[0]), qf[0], b0);
    f32x16 s1 = mfma(ldsv(Ks + 32 * rs + lo[0]), qf[0], b1);
    s0 = mfma(ldsv(Ks + lo[1]), qf[1], s0);
    s1 = mfma(ldsv(Ks + 32 * rs + lo[1]), qf[1], s1);
    if (need_mask) mask_causal(s0, s1, dl);
    if (__any(first || !(ls0[0] <= 1.0e12f) || !(ls0[1] <= 1.0e12f) || !(ls1[0] <= 1.0e12f) || !(ls1[1] <= 1.0e12f))) {
      float tmax = -INFINITY;
#pragma unroll
      for (int i = 0; i < 16; ++i) tmax = fmaxf(tmax, fmaxf(s0[i], s1[i]));
      tmax = fmaxf(tmax, shx(tmax, r + 32 * h));
      const float lmx = fmaxf(own_rowsum(ls0, r), own_rowsum(ls1, r));
      const float lref = (lmx > 1.f) ? lg2(lmx) : 0.f;
      const float delta = first ? tmax : fmaxf(fmaxf(tmax, lref), 0.f);
      m += delta;
      const float alpha = ex2(-delta);
      const float alpha_hi = shx(alpha, r + 32 * h, 16);
      ls0[0] *= alpha; ls0[1] *= alpha_hi; ls1[0] *= alpha; ls1[1] *= alpha_hi;
#pragma unroll
      for (int e = 0; e < 16; ++e) {
        o[0][0][e] *= alpha; o[0][1][e] *= alpha; o[1][0][e] *= alpha; o[1][1][e] *= alpha;
        s0[e] -= delta; s1[e] -= delta; b0[e] -= delta; b1[e] -= delta;
      }
    }
    pv_frag_step(s0, s1, Vs, o[0][0], o[0][1], ls0, ones, rs, lo);
  }
  {
    f32x16 s0 = mfma(ldsv(Ks + lo[2]), qf[2], b0);
    f32x16 s1 = mfma(ldsv(Ks + 32 * rs + lo[2]), qf[2], b1);
    s0 = mfma(ldsv(Ks + lo[3]), qf[3], s0);
    s1 = mfma(ldsv(Ks + 32 * rs + lo[3]), qf[3], s1);
    if (need_mask) mask_causal(s0, s1, dl);
    pv_frag_step(s0, s1, Vs, o[1][0], o[1][1], ls1, ones, rs, lo);
  }
}

DI void stick_pv(f32x16& s0, f32x16& s1, float& R, f32x16& o0, f32x16& o1, const u16* Vs, int dl,
                 bool need_mask, int r, int h) {
  float x[32];
#pragma unroll
  for (int t = 0; t < 2; ++t)
#pragma unroll
    for (int i = 0; i < 16; ++i) {
      const int ci = 32 * t + (i & 3) + 8 * (i >> 2);
      float a = t ? s1[i] : s0[i];
      float z = __builtin_amdgcn_fmed3f(a, -126.f, 126.f);
      float e = ex2(-z);
      float lb = -lg2(1.f + e);
      float xi = lb - z;
      if (need_mask) {
        bool valid = (ci < dl);
        xi = valid ? xi : 0.f;
        lb = valid ? lb : -INFINITY;
      }
      x[16 * t + i] = xi;
      if (t) s1[i] = lb; else s0[i] = lb;
    }
  float gs[8], pg[8], pr[8];
#pragma unroll
  for (int g = 0; g < 8; ++g) {
    gs[g] = (x[4 * g] + x[4 * g + 1]) + (x[4 * g + 2] + x[4 * g + 3]);
    pg[g] = shx(gs[g], r + 32 * h);
    pr[g] = gs[g] + pg[g];
  }
  float suf = 0.f;
#pragma unroll
  for (int g = 7; g >= 0; --g) {
    float base = R + suf + (h == 0 ? pg[g] : 0.f);
    float t3 = base, t2 = t3 + x[4 * g + 3], t1 = t2 + x[4 * g + 2], t0 = t1 + x[4 * g + 1];
    const int i = 4 * (g & 3);
    if (g >= 4) {
      s1[i] = ex2(s1[i] + t0); s1[i + 1] = ex2(s1[i + 1] + t1); s1[i + 2] = ex2(s1[i + 2] + t2); s1[i + 3] = ex2(s1[i + 3] + t3);
    } else {
      s0[i] = ex2(s0[i] + t0); s0[i + 1] = ex2(s0[i + 1] + t1); s0[i + 2] = ex2(s0[i + 2] + t2); s0[i + 3] = ex2(s0[i + 3] + t3);
    }
    suf += pr[g];
  }
  R += suf;
#pragma unroll
  for (int kk = 0; kk < 4; ++kk) {
    const int s = kk & 1;
    unsigned u0, u1, u2, u3;
    if (kk < 2) {
      u0 = pk2(s0[8 * s], s0[8 * s + 1]); u1 = pk2(s0[8 * s + 2], s0[8 * s + 3]);
      u2 = pk2(s0[8 * s + 4], s0[8 * s + 5]); u3 = pk2(s0[8 * s + 6], s0[8 * s + 7]);
    } else {
      u0 = pk2(s1[8 * s], s1[8 * s + 1]); u1 = pk2(s1[8 * s + 2], s1[8 * s + 3]);
      u2 = pk2(s1[8 * s + 4], s1[8 * s + 5]); u3 = pk2(s1[8 * s + 6], s1[8 * s + 7]);
    }
    u32x4 uu = {u0, u1, u2, u3};
    bf16x8 pf = __builtin_bit_cast(bf16x8, uu);
    bf16x8 v0 = ldsv(Vs + r * LSTR + kk * 16 + 8 * h);
    bf16x8 v1 = ldsv(Vs + (32 + r) * LSTR + kk * 16 + 8 * h);
    o0 = mfma(v0, pf, o0);
    o1 = mfma(v1, pf, o1);
  }
}

DI void load_gate_rows(u32x2 (&gv)[8], const u16* grow0, int lane) {
#pragma unroll
  for (int t = 0; t < 8; ++t) gv[t] = *(const u32x2*)(grow0 + (size_t)((lane >> 4) + 4 * t) * DIN + (lane & 15) * 4);
}
DI void store_y(const f32x16& oa, const f32x16& ob, float mult, const float* sg, const u32x2 (&gv)[8], u16* yrow0, float* stg,
                int lane, int r, int h) {
#pragma unroll
  for (int dt = 0; dt < 2; ++dt)
#pragma unroll
    for (int g = 0; g < 4; ++g) {
      f32x4 v;
      v[0] = (dt ? ob[4 * g] : oa[4 * g]) * mult; v[1] = (dt ? ob[4 * g + 1] : oa[4 * g + 1]) * mult;
      v[2] = (dt ? ob[4 * g + 2] : oa[4 * g + 2]) * mult; v[3] = (dt ? ob[4 * g + 3] : oa[4 * g + 3]) * mult;
      *(f32x4*)(stg + r * 68 + 32 * dt + 8 * g + 4 * h) = v;
    }
  const int kc = lane & 15;
  f32x4 sv = {1.f, 1.f, 1.f, 1.f};
  if (sg) sv = *(const f32x4*)(sg + kc * 4);
#pragma unroll
  for (int t = 0; t < 8; ++t) {
    const int row = (lane >> 4) + 4 * t;
    const f32x4 v = *(const f32x4*)(stg + row * 68 + kc * 4);
    float y0 = v[0] * sv[0] * silu(bflo(gv[t][0]));
    float y1 = v[1] * sv[1] * silu(bfhi(gv[t][0]));
    float y2 = v[2] * sv[2] * silu(bflo(gv[t][1]));
    float y3 = v[3] * sv[3] * silu(bfhi(gv[t][1]));
    u32x2 yo = {pk2(y0, y1), pk2(y2, y3)};
    *(u32x2*)(yrow0 + (size_t)row * DM + kc * 4) = yo;
  }
}

DI void attn_item_A(const Params& p, int layer, int b, int head, int qb, u16* sm, float lam, float lam_init, int wv) {
  const int tid = tid_now(wv), lane = tid & 63, w = tid >> 6, r = lane & 31, h = lane >> 5;
  const int qsub = w & 1, kh = w >> 1;
  const int q0 = qb * 64, q0w = q0 + 32 * qsub, qpos = q0w + r;
  const int qoff = head * 64, koff = 256 + head * 64, vh = head, goff = 768 + head * 64, yoff = head * 64;
  const u16* projb = p.proj + (size_t)b * SEQ * DIN;
  u16* Kb0 = sm + kh * (4 * 64 * 64);

  bf16x8 qf[4];
#pragma unroll
  for (int ks = 0; ks < 4; ++ks) qf[ks] = *(const bf16x8*)(projb + (size_t)qpos * DIN + qoff + 16 * ks + 8 * h);
  const float sl2 = exp2f(-8.f * (float)(9 + head) / 12.f) * LOG2E;
  int lo[4];
#pragma unroll
  for (int c = 0; c < 4; ++c) lo[c] = r * 64 + (((2 * c + h) ^ ((r >> 1) & 7)) * 8);

  const int t7 = tid & 127, wp = t7 >> 6;
  const int csrc = (lane & 7) ^ ((4 * wp + (lane >> 4)) & 7);
  const int row0 = wp * 8 + (lane >> 3);
  const u16* kg = projb + koff + csrc * 8;
  const u16* vg = p.vt + ((size_t)(b * NVH + vh) * 64) * SEQ + csrc * 8;

  float zf = 0.f;
  asm volatile("" : "+v"(zf));
  f32x16 o[2][2];
#pragma unroll
  for (int a = 0; a < 2; ++a)
#pragma unroll
    for (int d = 0; d < 2; ++d)
#pragma unroll
      for (int e = 0; e < 16; ++e) o[a][d][e] = zf;
  float m0 = 0.f, m1 = 0.f;
  f32x4 ls0 = {zf, zf, zf, zf}, ls1 = {zf, zf, zf, zf};
  const bf16x8 ones = rowsum_ones(lane);
  bool started = false;

  const int npairs = (qb >> 1) + 1;
  const int T0 = 2 * (npairs - 1) + kh;
  const bool v0 = (T0 <= qb);
  auto dma_tile = [&](int T, int c) {
    const int k0 = 64 * T;
    u16* Kd = Kb0 + c * (2 * 64 * 64) + wp * (8 * 64);
#pragma unroll
    for (int i = 0; i < 4; ++i) {
      __builtin_amdgcn_global_load_lds((const unsigned*)(kg + (size_t)(k0 + row0 + 16 * i) * DIN), (unsigned*)(Kd + i * 16 * 64), 16, 0, 0);
      __builtin_amdgcn_global_load_lds((const unsigned*)(vg + (size_t)(row0 + 16 * i) * SEQ + k0), (unsigned*)(Kd + 64 * 64 + i * 16 * 64), 16, 0, 0);
    }
  };
  if (v0) dma_tile(T0, 0);
  asm volatile("" :: "v"(qf[0]), "v"(qf[1]), "v"(qf[2]), "v"(qf[3]));
  asm volatile("s_waitcnt vmcnt(0)" ::: "memory");
  __syncthreads();
  for (int j = 0; j < npairs; ++j) {
    if (j + 1 < npairs) dma_tile(T0 - 2 * (j + 1), (j + 1) & 1);
    if (j > 0 || v0) {
      const int T = T0 - 2 * j;
      const u16* Ks = Kb0 + (j & 1) * (2 * 64 * 64);
      const u16* Vs = Ks + 64 * 64;
      const int k0 = 64 * T;
      const bool need_mask = (T == qb);
      const int dl = qpos - k0 - 4 * h;
      diff_softmax_pv(qf, Ks, Vs, m0, ls0, ls1, ones, o, sl2, dl, need_mask, !started, r, h, 64, lo);
      m1 = m0;
      started = true;
    }
    asm volatile("s_waitcnt vmcnt(0)" ::: "memory");
    __syncthreads();
  }

  if (!started) { m0 = -INFINITY; m1 = -INFINITY; }
  float l0 = own_rowsum(ls0, r), l1 = own_rowsum(ls1, r);
  u32x2 gate[8];
  if (kh == 0) load_gate_rows(gate, projb + (size_t)q0w * DIN + goff, lane);
  float* cb = (float*)sm + (size_t)qsub * 68 * 64 + lane;
  if (kh == 1) {
#pragma unroll
    for (int a = 0; a < 2; ++a)
#pragma unroll
      for (int d = 0; d < 2; ++d)
#pragma unroll
        for (int e = 0; e < 16; ++e) cb[((a * 2 + d) * 16 + e) * 64] = o[a][d][e];
    cb[64 * 64] = m0; cb[65 * 64] = l0; cb[66 * 64] = m1; cb[67 * 64] = l1;
  }
  __syncthreads();
  if (kh == 0) {
    {
      const float mb = cb[64 * 64], lb = cb[65 * 64];
      const float mn = fmaxf(m0, mb), fa = ex2(m0 - mn), fb = ex2(mb - mn);
      l0 = l0 * fa + lb * fb;
#pragma unroll
      for (int d = 0; d < 2; ++d)
#pragma unroll
        for (int e = 0; e < 16; ++e) o[0][d][e] = o[0][d][e] * fa + cb[((0 * 2 + d) * 16 + e) * 64] * fb;
    }
    {
      const float mb = cb[66 * 64], lb = cb[67 * 64];
      const float mn = fmaxf(m1, mb), fa = ex2(m1 - mn), fb = ex2(mb - mn);
      l1 = l1 * fa + lb * fb;
#pragma unroll
      for (int d = 0; d < 2; ++d)
#pragma unroll
        for (int e = 0; e < 16; ++e) o[1][d][e] = o[1][d][e] * fa + cb[((1 * 2 + d) * 16 + e) * 64] * fb;
    }
    const float inv0 = 1.f / l0, inv1 = lam / l1;
    float sq = 0.f;
#pragma unroll
    for (int dt = 0; dt < 2; ++dt)
#pragma unroll
      for (int e = 0; e < 16; ++e) {
        float v = o[0][dt][e] * inv0 - o[1][dt][e] * inv1;
        o[0][dt][e] = v;
        sq += v * v;
      }
    sq += shx(sq, lane);
    const float mult = __builtin_amdgcn_rsqf(sq * (1.f / 64.f) + EPS) * (1.f - lam_init);
    store_y(o[0][0], o[0][1], mult, p.subln_g + layer * 64, gate,
            p.y + ((size_t)b * SEQ + q0w) * DM + yoff, (float*)sm + 9216 + w * 2176, lane, r, h);
  }
}

template <int MODE>
DI void attn_item(const Params& p, int layer, int b, int head, int qblk, u16* sm, volatile LAS int* s_done_, int wv) {
  const int tid = tid_now(wv), lane = tid & 63, w = tid >> 6, r = lane & 31, h = lane >> 5;
  const int q0 = qblk * 128, q0w = q0 + 32 * w, qpos = q0w + r;
  int qoff, koff, vh, goff, yoff;
  if (MODE == 1) { qoff = 1024 + head * 64; koff = 1536 + (head >> 2) * 64; vh = 4 + (head >> 2); goff = 1792 + head * 64; yoff = 256 + head * 64; }
  else { qoff = 2304 + head * 64; koff = 2560 + head * 64; vh = 6 + head; goff = 3072 + head * 64; yoff = 768 + head * 64; }
  const u16* projb = p.proj + (size_t)b * SEQ * DIN;
  u16* Ks = sm;
  u16* Vs = sm + 64 * LSTR;

  bf16x8 qf[4];
#pragma unroll
  for (int ks = 0; ks < 4; ++ks) qf[ks] = *(const bf16x8*)(projb + (size_t)qpos * DIN + qoff + 16 * ks + 8 * h);

  float sl2 = 0.f;
  if (MODE == 1) sl2 = exp2f(-8.f * (float)(1 + head) / 12.f) * LOG2E;
  int lo[4];
#pragma unroll
  for (int c = 0; c < 4; ++c) lo[c] = r * LSTR + c * 16 + 8 * h;

  int it0 = 0, ntiles;
  if (MODE == 1) { ntiles = 4; it0 = (qblk == 0) ? 2 : 0; }
  else ntiles = 2 * (qblk + 1);

  const u16* kg = projb + koff + (tid & 7) * 8;
  const u16* vg = p.vt + ((size_t)(b * NVH + vh) * 64) * SEQ + (tid & 7) * 8;
  const int row0 = tid >> 3;
  const int loff = row0 * LSTR + (tid & 7) * 8;

  f32x16 o[2];
#pragma unroll
  for (int d = 0; d < 2; ++d)
#pragma unroll
    for (int e = 0; e < 16; ++e) o[d][e] = 0.f;
  float m0 = -INFINITY, R = 0.f;
  f32x16 ls0;
#pragma unroll
  for (int e = 0; e < 16; ++e) ls0[e] = (MODE == 1) ? 1.f : 0.f;
  if (MODE == 1) m0 = p.sinks[layer * 8 + head] * LOG2E;
  int wdone = 0;
  volatile LAS int* s_done = lds_fresh(s_done_);
  if (MODE == 2 && lane == 0) s_done[w] = 0;

  auto tile_k0 = [&](int it) -> int {
    if (MODE == 1) return q0 - 128 + 64 * it;
    return 64 * (ntiles - 1 - it);
  };
  u32x2 gate[8];
  load_gate_rows(gate, projb + (size_t)q0w * DIN + goff, lane);
  bool stop = false;
  for (int base = 0; base < ntiles && !stop; base += 4) {
    u32x4 rk[4][2], rv[4][2];
#pragma unroll
    for (int c = 0; c < 4; ++c) {
      const int it = base + c;
      if (it >= it0 && it < ntiles) {
        const int k0 = tile_k0(it);
#pragma unroll
        for (int i = 0; i < 2; ++i) {
          rk[c][i] = *(const u32x4*)(kg + (size_t)(k0 + row0 + 32 * i) * DIN);
          rv[c][i] = *(const u32x4*)(vg + (size_t)(row0 + 32 * i) * SEQ + k0);
        }
      }
    }
    __syncthreads();
    if (MODE == 2 && base > 0 && (s_done[0] & s_done[1] & s_done[2] & s_done[3])) { stop = true; }
    if (!stop) {
#pragma unroll
      for (int c = 0; c < 4; ++c) {
        const int it = base + c;
        if (it >= it0 && it < ntiles) {
#pragma unroll
          for (int i = 0; i < 2; ++i) {
            *(u32x4*)(Ks + c * (2 * 64 * LSTR) + loff + i * 32 * LSTR) = rk[c][i];
            *(u32x4*)(Vs + c * (2 * 64 * LSTR) + loff + i * 32 * LSTR) = rv[c][i];
          }
        }
      }
    }
    __syncthreads();
    if (!stop) {
#pragma unroll
      for (int c = 0; c < 4; ++c) {
        const int it = base + c;
        if (it >= it0 && it < ntiles) {
          const u16* Kc = Ks + c * (2 * 64 * LSTR);
          const u16* Vc = Vs + c * (2 * 64 * LSTR);
          const int k0 = tile_k0(it);
          bool skip, need_mask;
          if (MODE == 1) { skip = (k0 > q0w + 31) || (k0 + 63 < q0w - 127); need_mask = true; }
          else { skip = (k0 >= q0w + 31) || wdone; need_mask = (k0 + 63 >= q0w); }
          if (!skip) {
            const int dl = qpos - k0 - 4 * h;
            if (MODE == 1) {
              softmax_pv<1, 0, 4>(qf, Kc, Vc, m0, ls0, o[0], o[1], sl2, dl, need_mask, false, r, h, LSTR, lo);
            } else {
              f32x16 sa[2];
#pragma unroll
              for (int e = 0; e < 16; ++e) { sa[0][e] = 0.f; sa[1][e] = 0.f; }
#pragma unroll
              for (int t = 0; t < 2; ++t)
#pragma unroll
                for (int ks = 0; ks < 4; ++ks) {
                  bf16x8 kf = ldsv(Kc + (32 * t + r) * LSTR + ks * 16 + 8 * h);
                  sa[t] = mfma(kf, qf[ks], sa[t]);
                }
              stick_pv(sa[0], sa[1], R, o[0], o[1], Vc, dl, need_mask, r, h);
              wdone = __all(R < -160.f) ? 1 : 0;
            }
          }
        }
      }
      if (MODE == 2 && lane == 0) s_done[w] = wdone;
    }
  }
  __syncthreads();

  float inv = 1.f;
  if (MODE == 1) inv = 1.f / ls0[0];
  store_y(o[0], o[1], inv, nullptr, gate, p.y + ((size_t)b * SEQ + q0w) * DM + yoff,
          (float*)sm + 9216 + w * 2176, lane, r, h);
}

DI void attn_item_B2(const Params& p, int layer, int b, int head0, int qblk, u16* sm, int wv) {
  asm volatile("" : "+s"(head0));
  const int tid = tid_now(wv), lane = tid & 63, w = tid >> 6, r = lane & 31, h = lane >> 5;
  const int q0 = qblk * 128, q0w = q0 + 32 * w, qpos = q0w + r;
  const int koff = 1536 + (head0 >> 2) * 64, vh = 4 + (head0 >> 2);
  const u16* projb = p.proj + (size_t)b * SEQ * DIN;
  u16* Ks = sm;
  u16* Vs = sm + 64 * LSTR;
  const int it0 = (qblk == 0) ? 2 : 0;

  bf16x8 qf[2][4];
  u32x2 gate[2][8];
#pragma unroll
  for (int hh = 0; hh < 2; ++hh) {
#pragma unroll
    for (int ks = 0; ks < 4; ++ks)
      qf[hh][ks] = *(const bf16x8*)(projb + (size_t)qpos * DIN + 1024 + (head0 + hh) * 64 + 16 * ks + 8 * h);
    load_gate_rows(gate[hh], projb + (size_t)q0w * DIN + 1792 + (head0 + hh) * 64, lane);
  }
  int lo[4];
#pragma unroll
  for (int c = 0; c < 4; ++c) lo[c] = r * LSTR + c * 16 + 8 * h;

  const u16* kg = projb + koff + (tid & 7) * 8;
  const u16* vg = p.vt + ((size_t)(b * NVH + vh) * 64) * SEQ + (tid & 7) * 8;
  const int row0 = tid >> 3;
  const int loff = row0 * LSTR + (tid & 7) * 8;
  {
    u32x4 rk[4][2], rv[4][2];
#pragma unroll
    for (int c = 0; c < 4; ++c) {
      if (c >= it0) {
        const int k0 = q0 - 128 + 64 * c;
#pragma unroll
        for (int i = 0; i < 2; ++i) {
          rk[c][i] = *(const u32x4*)(kg + (size_t)(k0 + row0 + 32 * i) * DIN);
          rv[c][i] = *(const u32x4*)(vg + (size_t)(row0 + 32 * i) * SEQ + k0);
        }
      }
    }
    __syncthreads();
#pragma unroll
    for (int c = 0; c < 4; ++c) {
      if (c >= it0) {
#pragma unroll
        for (int i = 0; i < 2; ++i) {
          *(u32x4*)(Ks + c * (2 * 64 * LSTR) + loff + i * 32 * LSTR) = rk[c][i];
          *(u32x4*)(Vs + c * (2 * 64 * LSTR) + loff + i * 32 * LSTR) = rv[c][i];
        }
      }
    }
    __syncthreads();
  }
  float zf = 0.f, onef = 1.f;
  asm volatile("" : "+v"(zf), "+v"(onef));
  f32x16 o[2][2], ls[2];
  float mref[2];
#pragma unroll
  for (int hh = 0; hh < 2; ++hh) {
    const int head = head0 + hh;
    const float sl2 = exp2f(-8.f * (float)(1 + head) / 12.f) * LOG2E;
#pragma unroll
    for (int e = 0; e < 16; ++e) { o[hh][0][e] = zf; o[hh][1][e] = zf; ls[hh][e] = onef; }
    mref[hh] = p.sinks[layer * 8 + head] * LOG2E;
#pragma unroll
    for (int c = 0; c < 4; ++c) {
      if (c >= it0) {
        const int k0 = q0 - 128 + 64 * c;
        const bool skip = (k0 > q0w + 31) || (k0 + 63 < q0w - 127);
        if (!skip) {
          const int dl = qpos - k0 - 4 * h;
          softmax_pv<1, 0, 4>(qf[hh], Ks + c * (2 * 64 * LSTR), Vs + c * (2 * 64 * LSTR), mref[hh], ls[hh], o[hh][0], o[hh][1],
                              sl2, dl, true, false, r, h, LSTR, lo);
        }
      }
    }
  }
  __syncthreads();
#pragma unroll
  for (int hh = 0; hh < 2; ++hh)
    store_y(o[hh][0], o[hh][1], 1.f / ls[hh][0], nullptr, gate[hh], p.y + ((size_t)b * SEQ + q0w) * DM + 256 + (head0 + hh) * 64,
            (float*)sm + 9216 + w * 2176, lane, r, h);
}

__global__ void __launch_bounds__(256, 2) hymba_mega(Params p) {
  cg::grid_group grid = cg::this_grid();
  __shared__ __attribute__((aligned(16))) u16 sm[SMEM_U16];
  __shared__ int s_item;
  __shared__ int s_done[4];
  const int wv = __builtin_amdgcn_readfirstlane((int)threadIdx.x >> 6);
  const int bid = blockIdx.x, nb = gridDim.x;
  const int xcd = bid & 7, lb = bid >> 3, nxb = nb >> 3;
  __shared__ __attribute__((aligned(16))) unsigned xb_words[4];
  if (tid_now(wv) == 0) { xb_words[0] = 0u; xb_words[1] = 0u; xb_words[2] = 0u; xb_words[3] = 0u; }
  __syncthreads();
  const XcdBarrier gb = xcd_barrier_post(p.bar, (volatile LAS unsigned*)xb_words, wv);
  if (p.never) grid.sync();

  for (int rep = 0; rep < REP_PREP; ++rep) { phase_prep(p, sm, wv); xcd_barrier(gb); }

  for (int layer = 0; layer < DEPTH; ++layer) {
    for (int rep = 0; rep < REP_G0; ++rep) {
      for (int u = lb; u < 8 * 26; u += nxb) gemm_tile<0>(p, layer, xcd + 8 * (u & 7), u >> 3, sm, wv);
      xcd_barrier(gb);
    }

    {
      const float lam_init = 0.8f - 0.6f * expf(-0.3f * (float)layer);
      float d1 = 0.f, d2 = 0.f;
      for (int i = 0; i < 32; ++i) {
        d1 += p.lq1[layer * 32 + i] * p.lk1[layer * 32 + i];
        d2 += p.lq2[layer * 32 + i] * p.lk2[layer * 32 + i];
      }
      const float lam = expf(d1) - expf(d2) + lam_init;
      for (int rep = 0; rep < REP_ATT; ++rep) {
      if (rep) xcd_barrier(gb);
      unsigned* qctr = p.ctr + (rep * 2 + layer) * 8 + xcd;
      for (;;) {
        __syncthreads();
        volatile LAS int* sit = lds_fresh((volatile LAS int*)&s_item);
        if (tid_now(wv) == 0) *sit = (int)atomicAdd(qctr, 1u);
        __syncthreads();
        const int item = *sit;
        if (item >= N_ITEMS_XCD) break;
        const int slot = (item < 128) ? 0 : (item < 192) ? 1 : 3, per = (item < 128) ? 0 : (item < 192) ? item - 128 : item - 192;
        if (slot == 0 || slot == 2) {
          const int ia = item;
          if (!(rep && (0 < REP_LO || 128 > REP_HI)))
          attn_item_A(p, layer, xcd >> 2, xcd & 3, 127 - ia, sm, lam, lam_init, wv);
        } else if (slot == 1) {
          if (!(rep && (128 < REP_LO || 192 > REP_HI)))
          attn_item_B2(p, layer, (2 * xcd) >> 3, (2 * xcd) & 7, 63 - per, sm, wv);
        } else {
          if (!(rep && (192 < REP_LO || 256 > REP_HI)))
          attn_item<2>(p, layer, xcd >> 2, xcd & 3, 63 - per, sm, (volatile LAS int*)s_done, wv);
        }
      }
      }
    }
    xcd_barrier(gb);

    for (int u = lb; u < 8 * 8; u += nxb) gemm_tile<1>(p, layer, xcd + 8 * (u & 7), u >> 3, sm, wv);
    xcd_barrier(gb);
  }

  {
    const int tid = tid_now(wv), lane = tid & 63;
    const float* ssf = p.ss + (size_t)DEPTH * MTOK;
    f32x4 gv[4];
#pragma unroll
    for (int j = 0; j < 4; ++j) gv[j] = *(const f32x4*)(p.final_g + j * 256 + lane * 4);
    for (int row0 = (bid * 4 + (tid >> 6)) * 4; row0 < MTOK; row0 += nb * 16) {
      f32x4 xv[4][4];
      float rs[4];
#pragma unroll
      for (int q = 0; q < 4; ++q) {
        rs[q] = ssf[row0 + q];
#pragma unroll
        for (int j = 0; j < 4; ++j) {
          const u32x2 xb = *(const u32x2*)((const u16*)p.x2 + (size_t)(row0 + q) * DM + j * 256 + lane * 4);
          xv[q][j][0] = bflo(xb[0]); xv[q][j][1] = bfhi(xb[0]); xv[q][j][2] = bflo(xb[1]); xv[q][j][3] = bfhi(xb[1]);
        }
      }
#pragma unroll
      for (int q = 0; q < 4; ++q) {
        const float rq = __builtin_amdgcn_rsqf(rs[q] * (1.f / DM) + EPS);
#pragma unroll
        for (int j = 0; j < 4; ++j) {
          f32x4 v = xv[q][j];
          v[0] *= rq * gv[j][0]; v[1] *= rq * gv[j][1]; v[2] *= rq * gv[j][2]; v[3] *= rq * gv[j][3];
          *(f32x4*)(p.out + (size_t)(row0 + q) * DM + j * 256 + lane * 4) = v;
        }
      }
    }
  }
}

extern "C" void kernel_launch(void* const* d_in, const int* in_sizes, int n_in, void* d_out, int out_size, void* d_ws,
                              size_t ws_size, hipStream_t stream) {
  static int grid_blocks = 0;
  if (!grid_blocks) {
    int dev = 0, cus = 0, per_cu = 0;
    hipGetDevice(&dev);
    hipDeviceGetAttribute(&cus, hipDeviceAttributeMultiprocessorCount, dev);
    hipOccupancyMaxActiveBlocksPerMultiprocessor(&per_cu, hymba_mega, 256, 0);
    if (per_cu > 2) per_cu = 2;
    if (per_cu < 1) per_cu = 1;
    grid_blocks = cus * per_cu;
    grid_blocks -= grid_blocks % 8;
  }
  Params p{};
  p.x = (const float*)d_in[0]; p.norm_g = (const float*)d_in[1]; p.w_in = (const float*)d_in[2];
  p.lq1 = (const float*)d_in[3]; p.lk1 = (const float*)d_in[4]; p.lq2 = (const float*)d_in[5];
  p.lk2 = (const float*)d_in[6]; p.subln_g = (const float*)d_in[7]; p.sinks = (const float*)d_in[8];
  p.w_out = (const float*)d_in[9]; p.final_g = (const float*)d_in[10];
  p.out = (float*)d_out;
  char* ws = (char*)d_ws;
  size_t off = 0;
  auto take = [&](size_t bytes) { char* q = ws + off; off += (bytes + 255) & ~(size_t)255; return q; };
  p.wtin = (u16*)take((size_t)DEPTH * DIN * 1024 * 2);
  p.wtout = (u16*)take((size_t)DEPTH * 1024 * 1024 * 2);
  p.xg = (u16*)take((size_t)MTOK * DM * 2);
  p.proj = (u16*)take((size_t)MTOK * DIN * 2);
  p.vt = (u16*)take((size_t)NBATCH * NVH * 64 * SEQ * 2);
  p.y = (u16*)take((size_t)MTOK * DM * 2);
  p.ss = (float*)take((size_t)3 * MTOK * 4);
  p.ctr = (unsigned*)take(256);
  p.bar = (unsigned*)take((size_t)XCD_BAR_WORDS * 4);
  p.x2 = (float*)p.proj;
  p.never = 0;
  (void)hipMemsetAsync(p.bar, 0, (size_t)XCD_BAR_WORDS * 4, stream);
  void* args[] = {&p};
  hipError_t e = hipLaunchCooperativeKernel((void*)hymba_mega, dim3(grid_blocks), dim3(256), args, 0, stream);
  if (e != hipSuccess) fprintf(stderr, "cooperative launch failed: %s (grid %d)\n", hipGetErrorString(e), grid_blocks);
}
```

```cpp
#include <hip/hip_runtime.h>
#include <hip/hip_cooperative_groups.h>
#include <cstdio>
namespace cg = cooperative_groups;

#define DI __device__ __forceinline__
#define LAS __attribute__((address_space(3)))
typedef unsigned short u16;
typedef __attribute__((ext_vector_type(8))) __bf16 bf16x8;
typedef __attribute__((ext_vector_type(2))) __bf16 bf16x2;
typedef __attribute__((ext_vector_type(16))) float f32x16;
typedef __attribute__((ext_vector_type(2))) float f32x2;
typedef __attribute__((ext_vector_type(4))) unsigned u32x4;
typedef __attribute__((ext_vector_type(2))) unsigned u32x2;
typedef __attribute__((ext_vector_type(4))) float f32x4;

constexpr int SEQ = 8192, NBATCH = 2, DM = 1024, MTOK = NBATCH * SEQ, DIN = 3328, DEPTH = 2, NVH = 10;
constexpr float EPS = 1e-5f, LOG2E = 1.4426950408889634f;
constexpr int LSTR = 72;
constexpr int SMEM_U16 = 8 * 64 * LSTR;
constexpr int N_ITEMS_XCD = 128 + 64 + 64;
#ifndef REP_PREP
#define REP_PREP 1
#endif
#ifndef REP_G0
#define REP_G0 1
#endif
#ifndef REP_ATT
#define REP_ATT 1
#endif
#ifndef REP_LO
#define REP_LO 0
#endif
#ifndef REP_HI
#define REP_HI N_ITEMS_XCD
#endif

struct Params {
  const float *x, *norm_g, *w_in, *lq1, *lk1, *lq2, *lk2, *subln_g, *sinks, *w_out, *final_g;
  float* out;
  u16* wtin;
  u16* wtout;
  u16* xg;
  u16* proj;
  u16* vt;
  u16* y;
  float* ss;
  unsigned* ctr;
  unsigned* bar;
  float* x2;
  size_t never;
};

DI unsigned pk2(float a, float b) {
  f32x2 v = {a, b};
  bf16x2 r = __builtin_convertvector(v, bf16x2);
  return __builtin_bit_cast(unsigned, r);
}
DI uint2 pk4(float a, float b, float c, float d) { uint2 r; r.x = pk2(a, b); r.y = pk2(c, d); return r; }
DI float bflo(unsigned v) { return __uint_as_float(v << 16); }
DI float bfhi(unsigned v) { return __uint_as_float(v & 0xffff0000u); }
DI float ex2(float x) { return __builtin_amdgcn_exp2f(x); }

DI float lg2(float x) { return __builtin_amdgcn_logf(x); }
DI f32x16 mfma(bf16x8 a, bf16x8 b, f32x16 c) { return __builtin_amdgcn_mfma_f32_32x32x16_bf16(a, b, c, 0, 0, 0); }
DI bf16x8 ldsv(const u16* p) { return *(const bf16x8*)p; }
DI float silu(float g) { return g * __builtin_amdgcn_rcpf(1.f + ex2(-g * LOG2E)); }
DI int tid_now(int wv) {
  int t;
  asm volatile("v_mbcnt_lo_u32_b32 %0, -1, 0\n\tv_mbcnt_hi_u32_b32 %0, -1, %0" : "=v"(t));
  return wv * 64 + t;
}
DI float shx(float v, int lane, int o = 32) {
  return __int_as_float(__builtin_amdgcn_ds_bpermute((lane ^ o) << 2, __float_as_int(v)));
}
template <typename T> DI volatile LAS T* lds_fresh(volatile LAS T* q) { asm volatile("" : "+v"(q)); return q; }
DI float wave_sum(float v, int lane) {
#pragma unroll
  for (int o = 32; o >= 1; o >>= 1) v += shx(v, lane, o);
  return v;
}


#define XB_TMO      128
#define XB_XCNT(j)  (256  + 64 * (j))
#define XB_XSUB(j)  (1280 + 64 * (j))
#define XB_XGEN(j)  (2304 + 64 * (j))
#define XB_TOP      3328
#define XB_TOPGEN   3392
#define XCD_BAR_WORDS 3456
#define XB_SPIN_CAP (1u << 18)
DI unsigned xb_ld(unsigned* p) { return __hip_atomic_load(p, __ATOMIC_RELAXED, __HIP_MEMORY_SCOPE_AGENT); }
DI unsigned xb_add(unsigned* p, unsigned v) { return __hip_atomic_fetch_add(p, v, __ATOMIC_RELAXED, __HIP_MEMORY_SCOPE_AGENT); }
DI unsigned xb_xcc_id() { return (unsigned)__builtin_amdgcn_s_getreg((3 << 11) | 20) & 0xFu; }
#define XB_SPIN(cond, bar) do { unsigned _sp = 0; while (cond) { __builtin_amdgcn_s_sleep(1); \
    if ((++_sp & 255u) == 0u) { if (xb_ld(&(bar)[XB_TMO])) break; if (_sp > XB_SPIN_CAP) { atomicAdd(&(bar)[XB_TMO], 1u); break; } } } } while (0)
struct XcdBarrier { unsigned* bar; unsigned x; volatile LAS unsigned* st; int wv; };
DI XcdBarrier xcd_barrier_post(unsigned* bar, volatile LAS unsigned* st, int wv) {
  XcdBarrier b; b.bar = bar; b.x = xb_xcc_id(); b.st = st; b.wv = wv;
  if (tid_now(wv) == 0) (void)xb_add(&bar[XB_XCNT(b.x)], 1u);
  return b;
}
DI void xcd_barrier_complete(unsigned* bar, unsigned x, unsigned& nloc, unsigned& nx) {
  const unsigned G = gridDim.x * gridDim.y * gridDim.z;
  unsigned sum, cnt, mine, sp = 0u;
  for (;;) {
    sum = 0u; cnt = 0u; mine = 0u;
#pragma unroll
    for (unsigned j = 0; j < 16; ++j) { const unsigned c = xb_ld(&bar[XB_XCNT(j)]); sum += c; cnt += (c > 0u) ? 1u : 0u; mine = (j == x) ? c : mine; }
    if (sum == G) break;
    __builtin_amdgcn_s_sleep(1);
    if ((++sp & 255u) == 0u) { if (xb_ld(&bar[XB_TMO])) break; if (sp > XB_SPIN_CAP) { atomicAdd(&bar[XB_TMO], 1u); break; } }
  }
  nloc = mine > 0u ? mine : 1u; nx = cnt > 0u ? cnt : 1u;
}
DI void xcd_barrier(const XcdBarrier& b) {
  asm volatile("s_waitcnt vmcnt(0)" ::: "memory");
  __syncthreads();
  if (tid_now(b.wv) == 0) {
    unsigned* bar = b.bar;
    __builtin_amdgcn_s_waitcnt(0);
    volatile LAS unsigned* st = lds_fresh(b.st);
    unsigned nloc = st[0], nx = st[1];
    if (nloc == 0u) { xcd_barrier_complete(bar, b.x, nloc, nx); st[0] = nloc; st[1] = nx; }
    const unsigned old = xb_add(&bar[XB_XSUB(b.x)], 1u);
    const unsigned gen = old / nloc;
    if (old + 1u == (gen + 1u) * nloc) {
      __builtin_amdgcn_fence(__ATOMIC_RELEASE, "agent");
      asm volatile("s_waitcnt vmcnt(0)" ::: "memory");
      const unsigned og = xb_add(&bar[XB_TOP], 1u);
      const unsigned tg = og / nx;
      if (og + 1u == (tg + 1u) * nx) xb_add(&bar[XB_TOPGEN], 1u);
      else XB_SPIN(xb_ld(&bar[XB_TOPGEN]) == tg, bar);
      __builtin_amdgcn_fence(__ATOMIC_ACQUIRE, "agent");
      xb_add(&bar[XB_XGEN(b.x)], 1u);
      asm volatile("s_waitcnt vmcnt(0)" ::: "memory");
    } else {
      XB_SPIN(xb_ld(&bar[XB_XGEN(b.x)]) == gen, bar);
      __builtin_amdgcn_fence(__ATOMIC_ACQUIRE, "agent");
      asm volatile("s_waitcnt vmcnt(0)" ::: "memory");
    }
  }
  __syncthreads();
}

DI void phase_prep(const Params& p, u16* sm, int wv) {
  const int tid = tid_now(wv), nb = gridDim.x, bid = blockIdx.x;
  float* smf = (float*)sm;
  constexpr int T_IN = DEPTH * 16 * 52, T_OUT = DEPTH * 16 * 16;
  for (int t = bid; t < T_IN + T_OUT; t += nb) {
    const float* src; u16* dst; int N, kt, nt; const float* gsc = nullptr;
    if (t < T_IN) {
      int l = t / 832, rr = t % 832; kt = rr / 52; nt = rr % 52; N = DIN;
      src = p.w_in + (size_t)l * 1024 * DIN; dst = p.wtin + (size_t)l * DIN * 1024; gsc = p.norm_g + l * DM;
    } else {
      int u = t - T_IN; int l = u / 256, rr = u % 256; kt = rr / 16; nt = rr % 16; N = 1024;
      src = p.w_out + (size_t)l * 1024 * 1024; dst = p.wtout + (size_t)l * 1024 * 1024;
    }
    __syncthreads();
#pragma unroll
    for (int i = 0; i < 4; ++i) {
      const int k = i * 16 + (tid >> 4), n4 = (tid & 15) * 4;
      const f32x4 v = __builtin_nontemporal_load((const f32x4*)(src + (size_t)(kt * 64 + k) * N + nt * 64 + n4));
      const float gk = gsc ? gsc[kt * 64 + k] : 1.f;
      smf[(n4 + 0) * 65 + k] = v[0] * gk; smf[(n4 + 1) * 65 + k] = v[1] * gk;
      smf[(n4 + 2) * 65 + k] = v[2] * gk; smf[(n4 + 3) * 65 + k] = v[3] * gk;
    }
    __syncthreads();
#pragma unroll
    for (int j = 0; j < 2; ++j) {
      const int c = tid + 256 * j, kc = c & 7, n = c >> 3;
      const float* q = smf + n * 65 + kc * 8;
      u32x4 o = {pk2(q[0], q[1]), pk2(q[2], q[3]), pk2(q[4], q[5]), pk2(q[6], q[7])};
      *(u32x4*)(dst + (size_t)(nt * 64 + n) * 1024 + kt * 64 + kc * 8) = o;
    }
  }
  const int lane = tid & 63;
  {
    for (int row0 = (bid * 4 + (tid >> 6)) * 4; row0 < MTOK; row0 += nb * 16) {
      f32x4 xv[4][4];
#pragma unroll
      for (int q = 0; q < 4; ++q)
#pragma unroll
        for (int j = 0; j < 4; ++j) xv[q][j] = __builtin_nontemporal_load((const f32x4*)(p.x + (size_t)(row0 + q) * DM + j * 256 + lane * 4));
#pragma unroll
      for (int q = 0; q < 4; ++q) {
        float sq = 0.f;
#pragma unroll
        for (int j = 0; j < 4; ++j) {
          const f32x4 v = xv[q][j];
          sq += v[0] * v[0] + v[1] * v[1] + v[2] * v[2] + v[3] * v[3];
          u32x2 o = {pk2(v[0], v[1]), pk2(v[2], v[3])};
          *(u32x2*)(p.xg + (size_t)(row0 + q) * DM + j * 256 + lane * 4) = o;
        }
        sq = wave_sum(sq, lane);
        if (lane == 0) p.ss[row0 + q] = sq;
      }
    }
  }
  for (int i = bid * 256 + tid; i < 2 * MTOK; i += nb * 256) p.ss[MTOK + i] = 0.f;
  if (bid == 0 && tid < 64) p.ctr[tid] = 0u;
}

constexpr int GSTR = 80;
DI f32x4 mfma16(bf16x8 a, bf16x8 b, f32x4 c) { return __builtin_amdgcn_mfma_f32_16x16x32_bf16(a, b, c, 0, 0, 0); }

template <bool VT>
DI void gemm_kslab(f32x4 (&acc)[8][4], const u16* sA, const u16* sB, int wm, int wn, int fr, int fq) {
#pragma unroll
  for (int ks = 0; ks < 2; ++ks) {
    bf16x8 tb[4], ta[8];
#pragma unroll
    for (int j = 0; j < 4; ++j) tb[j] = ldsv(sB + (wn * 64 + 16 * j + fr) * GSTR + ks * 32 + 8 * fq);
#pragma unroll
    for (int i = 0; i < 8; ++i) ta[i] = ldsv(sA + (wm * 128 + 16 * i + fr) * GSTR + ks * 32 + 8 * fq);
#pragma unroll
    for (int i = 0; i < 8; ++i)
#pragma unroll
      for (int j = 0; j < 4; ++j)
        acc[i][j] = VT ? mfma16(ta[i], tb[j], acc[i][j]) : mfma16(tb[j], ta[i], acc[i][j]);
  }
  __builtin_amdgcn_sched_group_barrier(0x100, 6, 0);
#pragma unroll
  for (int g = 0; g < 6; ++g) {
    __builtin_amdgcn_sched_group_barrier(0x008, 4, 0);
    __builtin_amdgcn_sched_group_barrier(0x100, 1, 0);
  }
  __builtin_amdgcn_sched_group_barrier(0x100, 6, 0);
  __builtin_amdgcn_sched_group_barrier(0x008, 8, 0);
#pragma unroll
  for (int g = 0; g < 6; ++g) {
    __builtin_amdgcn_sched_group_barrier(0x008, 4, 0);
    __builtin_amdgcn_sched_group_barrier(0x100, 1, 0);
  }
  __builtin_amdgcn_sched_group_barrier(0x008, 8, 0);
}

template <bool VT>
DI void gemm_mainloop(f32x4 (&acc)[8][4], const char* abase, const char* bbase, unsigned toff, u16* sA, u16* sB, int loff, int wm, int wn, int fr, int fq) {
  const __amdgpu_buffer_rsrc_t ra_rs = __builtin_amdgcn_make_buffer_rsrc((void*)abase, (short)0, 256 * 2048, 0x00020000);
  const __amdgpu_buffer_rsrc_t rb_rs = __builtin_amdgcn_make_buffer_rsrc((void*)bbase, (short)0, 128 * 2048, 0x00020000);
  u32x4 ra[8], rb[4];
#pragma unroll
  for (int i = 0; i < 8; ++i) ra[i] = __builtin_amdgcn_raw_buffer_load_b128(ra_rs, (int)toff, i * 65536, 0);
#pragma unroll
  for (int i = 0; i < 4; ++i) rb[i] = __builtin_amdgcn_raw_buffer_load_b128(rb_rs, (int)toff, i * 65536, 0);
#pragma unroll 1
  for (int kt = 0; kt < 16; ++kt) {
    __syncthreads();
#pragma unroll
    for (int i = 0; i < 8; ++i) *(u32x4*)(sA + loff + i * 32 * GSTR) = ra[i];
#pragma unroll
    for (int i = 0; i < 4; ++i) *(u32x4*)(sB + loff + i * 32 * GSTR) = rb[i];
    __syncthreads();
    if (kt + 1 < 16) {
      const int ko = (kt + 1) * 128;
#pragma unroll
      for (int i = 0; i < 8; ++i) ra[i] = __builtin_amdgcn_raw_buffer_load_b128(ra_rs, (int)toff, i * 65536 + ko, 0);
#pragma unroll
      for (int i = 0; i < 4; ++i) rb[i] = __builtin_amdgcn_raw_buffer_load_b128(rb_rs, (int)toff, i * 65536 + ko, 0);
    }
    gemm_kslab<VT>(acc, sA, sB, wm, wn, fr, fq);
  }
}

template <int EPI>
DI void gemm_tile(const Params& p, int layer, int mt, int nt, u16* sm, int wv) {
  const int tid = tid_now(wv), w = tid >> 6;
  int lane = tid & 63, fr = lane & 15, fq = lane >> 4;
  const u16* A = (EPI == 0) ? p.xg : p.y;
  const u16* Bt = (EPI == 0) ? p.wtin + (size_t)layer * DIN * 1024 : p.wtout + (size_t)layer * 1024 * 1024;
  const int m0 = mt * 256, n0 = nt * 128;
  const char* abase = (const char*)(A + (size_t)m0 * 1024);
  const char* bbase = (const char*)(Bt + (size_t)n0 * 1024);
  const unsigned toff = (unsigned)(tid >> 3) * 2048u + (unsigned)(tid & 7) * 16u;
  const int loff = (tid >> 3) * GSTR + (tid & 7) * 8;
  u16* sA = sm;
  u16* sB = sm + 256 * GSTR;
  f32x4 acc[8][4];
#pragma unroll
  for (int i = 0; i < 8; ++i)
#pragma unroll
    for (int j = 0; j < 4; ++j)
#pragma unroll
      for (int e = 0; e < 4; ++e) acc[i][j][e] = 0.f;

  bool vtile = false;
  if (EPI == 0) vtile = (nt == 4 || nt == 5 || nt == 13 || nt == 22 || nt == 23);
  int wm = w >> 1, wn = w & 1;

  if (EPI == 0 && vtile) { asm volatile("; v-tile main loop" ::: "memory"); gemm_mainloop<true>(acc, abase, bbase, toff, sA, sB, loff, wm, wn, fr, fq); }
  else { asm volatile("; main loop" ::: "memory"); gemm_mainloop<false>(acc, abase, bbase, toff, sA, sB, loff, wm, wn, fr, fq); }

  {
    const int t2 = tid_now(wv);
    const int l2 = t2 & 63, w2 = t2 >> 6;
    lane = l2; fr = l2 & 15; fq = l2 >> 4; wm = w2 >> 1; wn = w2 & 1;
  }
  if (EPI == 0) {
    const float* ssl = p.ss + (size_t)layer * MTOK;
    __syncthreads();
    u16* stg = sm + (wm * 2 + wn) * (128 * LSTR);
    if (!vtile) {
      const float qsc = (nt < 2) ? 0.17677669529663687f * LOG2E
                        : ((nt >= 8 && nt < 12) || nt == 18 || nt == 19) ? 0.125f * LOG2E : 1.f;
#pragma unroll
      for (int i = 0; i < 8; ++i) {
        const int m = m0 + wm * 128 + 16 * i + fr;
        const float rs = __builtin_amdgcn_rsqf(ssl[m] * (1.f / DM) + EPS) * qsc;
        u16* d = stg + (16 * i + fr) * LSTR + 4 * fq;
#pragma unroll
        for (int j = 0; j < 4; ++j) {
          u32x2 v = {pk2(acc[i][j][0] * rs, acc[i][j][1] * rs), pk2(acc[i][j][2] * rs, acc[i][j][3] * rs)};
          *(u32x2*)(d + 16 * j) = v;
        }
      }
      u16* gdst = p.proj + (size_t)(m0 + wm * 128) * DIN + n0 + wn * 64;
#pragma unroll
      for (int t = 0; t < 16; ++t) {
        const int c = lane + 64 * t, row = c >> 3, kc = c & 7;
        const u32x4 v = *(const u32x4*)(stg + row * LSTR + kc * 8);
        *(u32x4*)(gdst + (size_t)row * DIN + kc * 8) = v;
      }
    } else {
      const int vbase = (nt == 4) ? 0 : (nt == 5) ? 2 : (nt == 13) ? 4 : (nt == 22) ? 6 : 8;
      const int bb = m0 / SEQ, s0 = m0 % SEQ;
      constexpr int VSTR = 136;
#pragma unroll
      for (int i = 0; i < 8; ++i) {
        float rs[4];
#pragma unroll
        for (int e = 0; e < 4; ++e) rs[e] = __builtin_amdgcn_rsqf(ssl[m0 + wm * 128 + 16 * i + 4 * fq + e] * (1.f / DM) + EPS);
        const int pos = 16 * i + 8 * (fq & 1) + 4 * (fq >> 1);
#pragma unroll
        for (int j = 0; j < 4; ++j) {
          u32x2 v = {pk2(acc[i][j][0] * rs[0], acc[i][j][1] * rs[1]), pk2(acc[i][j][2] * rs[2], acc[i][j][3] * rs[3])};
          *(u32x2*)(stg + (16 * j + fr) * VSTR + pos) = v;
        }
      }
      u16* gdst = p.vt + ((size_t)(bb * NVH + vbase + wn) * 64) * SEQ + s0 + wm * 128;
#pragma unroll
      for (int t = 0; t < 16; ++t) {
        const int c = lane + 64 * t, row = c >> 4, kc = c & 15;
        const u32x4 v = *(const u32x4*)(stg + row * VSTR + kc * 8);
        *(u32x4*)(gdst + (size_t)row * SEQ + kc * 8) = v;
      }
    }
  } else {
    const bool has_next = (layer + 1 < DEPTH);
    float* ssn = p.ss + (size_t)(layer + 1) * MTOK;
    __syncthreads();
    float* stg = (float*)(sm + (wm * 2 + wn) * (128 * LSTR));
    const int kc = lane & 15;
#pragma unroll
    for (int hh = 0; hh < 2; ++hh) {
#pragma unroll
      for (int i2 = 0; i2 < 4; ++i2)
#pragma unroll
        for (int j = 0; j < 4; ++j)
          *(f32x4*)(stg + (16 * i2 + fr) * 68 + 16 * j + 4 * fq) = acc[4 * hh + i2][j];
      const size_t mrow0 = (size_t)(m0 + wm * 128 + 64 * hh);
      u16* xrow = p.xg + mrow0 * DM + n0 + wn * 64 + kc * 4;
      u16* x2row = (u16*)p.x2 + mrow0 * DM + n0 + wn * 64 + kc * 4;
      u32x2 xb[16];
#pragma unroll
      for (int t = 0; t < 16; ++t) xb[t] = __builtin_nontemporal_load((const u32x2*)(xrow + (size_t)((lane >> 4) + 4 * t) * DM));
#pragma unroll
      for (int t = 0; t < 16; ++t) {
        const int row = (lane >> 4) + 4 * t;
        const f32x4 a4 = *(const f32x4*)(stg + row * 68 + kc * 4);
        const float v0 = bflo(xb[t][0]) + a4[0], v1 = bfhi(xb[t][0]) + a4[1], v2 = bflo(xb[t][1]) + a4[2], v3 = bfhi(xb[t][1]) + a4[3];
        float sq = v0 * v0 + v1 * v1 + v2 * v2 + v3 * v3;
        u32x2 pv = {pk2(v0, v1), pk2(v2, v3)};
        if (has_next) *(u32x2*)(xrow + (size_t)row * DM) = pv;
        else *(u32x2*)(x2row + (size_t)row * DM) = pv;
        sq += shx(sq, lane, 1); sq += shx(sq, lane, 2); sq += shx(sq, lane, 4); sq += shx(sq, lane, 8);
        if (kc == 0) atomicAdd(ssn + mrow0 + row, sq);
      }
    }
  }
}

template <int MODE, int KS0, int NKS>
DI void qk_scores(f32x16& s0, f32x16& s1, const u16* Ks, const bf16x8 (&qf)[4], float sl2, int dl, float mref,
                  bool need_mask, int r, int h, int rs, const int (&lo)[4]) {
  asm volatile("" : "+v"(dl));
  const float nb = -sl2 * (float)dl - mref;
#pragma unroll
  for (int i = 0; i < 16; ++i) {
    const int ci = (i & 3) + 8 * (i >> 2);
    s0[i] = fmaf(sl2, (float)ci, nb);
    s1[i] = fmaf(sl2, (float)(ci + 32), nb);
  }
#pragma unroll
  for (int ks = 0; ks < NKS; ++ks) {
    bf16x8 k0 = ldsv(Ks + lo[KS0 + ks]);
    bf16x8 k1 = ldsv(Ks + 32 * rs + lo[KS0 + ks]);
    s0 = mfma(k0, qf[KS0 + ks], s0);
    s1 = mfma(k1, qf[KS0 + ks], s1);
  }
  if (need_mask) {
#pragma unroll
    for (int i = 0; i < 16; ++i) {
      const int ci = (i & 3) + 8 * (i >> 2);
      bool v0 = (MODE == 0) ? (ci <= dl) : (ci <= dl && ci > dl - 128);
      bool v1 = (MODE == 0) ? (ci + 32 <= dl) : (ci + 32 <= dl && ci + 32 > dl - 128);
      s0[i] = v0 ? s0[i] : -INFINITY;
      s1[i] = v1 ? s1[i] : -INFINITY;
    }
  }
}
template <int MODE, int KS0, int NKS>
DI void softmax_pv(const bf16x8 (&qf)[4], const u16* Ks, const u16* Vs, float& m, f32x16& ls, f32x16& o0, f32x16& o1,
                   float sl2, int dl, bool need_mask, bool first, int r, int h, int rs, const int (&lo)[4]) {
  f32x16 s0, s1;
  qk_scores<MODE, KS0, NKS>(s0, s1, Ks, qf, sl2, dl, m, need_mask, r, h, rs, lo);
  if (__any(first || !(ls[0] <= 1.0e12f))) {
    float tmax = -INFINITY;
#pragma unroll
    for (int i = 0; i < 16; ++i) tmax = fmaxf(tmax, fmaxf(s0[i], s1[i]));
    tmax = fmaxf(tmax, shx(tmax, r + 32 * h));
    const float lref = (ls[0] > 1.f) ? lg2(ls[0]) : 0.f;
    const float delta = first ? tmax : fmaxf(fmaxf(tmax, lref), 0.f);
    m += delta;
    const float alpha = ex2(-delta);
#pragma unroll
    for (int e = 0; e < 16; ++e) { o0[e] *= alpha; o1[e] *= alpha; ls[e] *= alpha; }
#pragma unroll
    for (int i = 0; i < 16; ++i) { s0[i] -= delta; s1[i] -= delta; }
  }
#pragma unroll
  for (int i = 0; i < 16; ++i) { s0[i] = ex2(s0[i]); s1[i] = ex2(s1[i]); }
  const u32x4 one4 = {0x3f803f80u, 0x3f803f80u, 0x3f803f80u, 0x3f803f80u};
  const bf16x8 ones = __builtin_bit_cast(bf16x8, one4);
#pragma unroll
  for (int kk = 0; kk < 4; ++kk) {
    const int s = kk & 1;
    unsigned u0, u1, u2, u3;
    if (kk < 2) {
      u0 = pk2(s0[8 * s], s0[8 * s + 1]); u1 = pk2(s0[8 * s + 2], s0[8 * s + 3]);
      u2 = pk2(s0[8 * s + 4], s0[8 * s + 5]); u3 = pk2(s0[8 * s + 6], s0[8 * s + 7]);
    } else {
      u0 = pk2(s1[8 * s], s1[8 * s + 1]); u1 = pk2(s1[8 * s + 2], s1[8 * s + 3]);
      u2 = pk2(s1[8 * s + 4], s1[8 * s + 5]); u3 = pk2(s1[8 * s + 6], s1[8 * s + 7]);
    }
    u32x4 uu = {u0, u1, u2, u3};
    bf16x8 pf = __builtin_bit_cast(bf16x8, uu);
    bf16x8 v0 = ldsv(Vs + lo[kk]);
    bf16x8 v1 = ldsv(Vs + 32 * rs + lo[kk]);
    o0 = mfma(v0, pf, o0);
    o1 = mfma(v1, pf, o1);
    ls = mfma(ones, pf, ls);
  }
}

DI void pv_frag_step(f32x16& s0, f32x16& s1, const u16* Vs, f32x16& o0, f32x16& o1, f32x4& ls, bf16x8 ones, int rs, const int (&lo)[4]) {
#pragma unroll
  for (int i = 0; i < 16; ++i) { s0[i] = ex2(s0[i]); s1[i] = ex2(s1[i]); }
#pragma unroll
  for (int kk = 0; kk < 4; ++kk) {
    const int s = kk & 1;
    unsigned u0, u1, u2, u3;
    if (kk < 2) {
      u0 = pk2(s0[8 * s], s0[8 * s + 1]); u1 = pk2(s0[8 * s + 2], s0[8 * s + 3]);
      u2 = pk2(s0[8 * s + 4], s0[8 * s + 5]); u3 = pk2(s0[8 * s + 6], s0[8 * s + 7]);
    } else {
      u0 = pk2(s1[8 * s], s1[8 * s + 1]); u1 = pk2(s1[8 * s + 2], s1[8 * s + 3]);
      u2 = pk2(s1[8 * s + 4], s1[8 * s + 5]); u3 = pk2(s1[8 * s + 6], s1[8 * s + 7]);
    }
    u32x4 uu = {u0, u1, u2, u3};
    bf16x8 pf = __builtin_bit_cast(bf16x8, uu);
    bf16x8 v0 = ldsv(Vs + lo[kk]);
    bf16x8 v1 = ldsv(Vs + 32 * rs + lo[kk]);
    o0 = mfma(v0, pf, o0);
    o1 = mfma(v1, pf, o1);
    ls = mfma16(ones, pf, ls);
  }
}
DI void mask_causal(f32x16& s0, f32x16& s1, int dl) {
#pragma unroll
  for (int i = 0; i < 16; ++i) {
    const int ci = (i & 3) + 8 * (i >> 2);
    s0[i] = (ci <= dl) ? s0[i] : -INFINITY;
    s1[i] = (ci + 32 <= dl) ? s1[i] : -INFINITY;
  }
}
DI float bperm(float v, int srclane) { return __int_as_float(__builtin_amdgcn_ds_bpermute(srclane << 2, __float_as_int(v))); }
DI float own_rowsum(const f32x4& ls, int r) {
  const float a = bperm(ls[0], r & 15), b = bperm(ls[1], r & 15);
  return (r >> 4) ? b : a;
}
DI bf16x8 rowsum_ones(int lane) {
  const int fr16 = lane & 15, g = lane >> 4;
  const unsigned w = (fr16 < 2 && fr16 == (g & 1)) ? 0x3f803f80u : 0u;
  const u32x4 v = {w, w, w, w};
  return __builtin_bit_cast(bf16x8, v);
}
DI void diff_softmax_pv(const bf16x8 (&qf)[4], const u16* Ks, const u16* Vs, float& m, f32x4& ls0, f32x4& ls1, bf16x8 ones,
                        f32x16 (&o)[2][2], float sl2, int dl, bool need_mask, bool first, int r, int h, int rs, const int (&lo)[4]) {
  f32x16 b0, b1;
  const float nb = -sl2 * (float)dl - m;
#pragma unroll
  for (int i = 0; i < 16; ++i) {
    const int ci = (i & 3) + 8 * (i >> 2);
    b0[i] = fmaf(sl2, (float)ci, nb);
    b1[i] = fmaf(sl2, (float)(ci + 32), nb);
  }
  {
    f32x16 s0 = mfma(ldsv(Ks + lo[0]), qf[0], b0);
    f32x16 s1 = mfma(ldsv(Ks + 32 * rs + lo[0]), qf[0], b1);
    s0 = mfma(ldsv(Ks + lo[1]), qf[1], s0);
    s1 = mfma(ldsv(Ks + 32 * rs + lo[1]), qf[1], s1);
    if (need_mask) mask_causal(s0, s1, dl);
    if (__any(first || !(ls0[0] <= 1.0e12f) || !(ls0[1] <= 1.0e12f) || !(ls1[0] <= 1.0e12f) || !(ls1[1] <= 1.0e12f))) {
      float tmax = -INFINITY;
#pragma unroll
      for (int i = 0; i < 16; ++i) tmax = fmaxf(tmax, fmaxf(s0[i], s1[i]));
      tmax = fmaxf(tmax, shx(tmax, r + 32 * h));
      const float lmx = fmaxf(own_rowsum(ls0, r), own_rowsum(ls1, r));
      const float lref = (lmx > 1.f) ? lg2(lmx) : 0.f;
      const float delta = first ? tmax : fmaxf(fmaxf(tmax, lref), 0.f);
      m += delta;
      const float alpha = ex2(-delta);
      const float alpha_hi = shx(alpha, r + 32 * h, 16);
      ls0[0] *= alpha; ls0[1] *= alpha_hi; ls1[0] *= alpha; ls1[1] *= alpha_hi;
#pragma unroll
      for (int e = 0; e < 16; ++e) {
        o[0][0][e] *= alpha; o[0][1][e] *= alpha; o[1][0][e] *= alpha; o[1][1][e] *= alpha;
        s0[e] -= delta; s1[e] -= delta; b0[e] -= delta; b1[e] -= delta;
      }
    }
    pv_frag_step(s0, s1, Vs, o[0][0], o[0][1], ls0, ones, rs, lo);
  }
  {
    f32x16 s0 = mfma(ldsv(Ks + lo[2]), qf[2], b0);
    f32x16 s1 = mfma(ldsv(Ks + 32 * rs + lo[2]), qf[2], b1);
    s0 = mfma(ldsv(Ks + lo[3]), qf[3], s0);
    s1 = mfma(ldsv(Ks + 32 * rs + lo[3]), qf[3], s1);
    if (need_mask) mask_causal(s0, s1, dl);
    pv_frag_step(s0, s1, Vs, o[1][0], o[1][1], ls1, ones, rs, lo);
  }
}

DI void stick_pv(f32x16& s0, f32x16& s1, float& R, f32x16& o0, f32x16& o1, const u16* Vs, int dl,
                 bool need_mask, int r, int h) {
  float x[32];
#pragma unroll
  for (int t = 0; t < 2; ++t)
#pragma unroll
    for (int i = 0; i < 16; ++i) {
      const int ci = 32 * t + (i & 3) + 8 * (i >> 2);
      float a = t ? s1[i] : s0[i];
      float z = __builtin_amdgcn_fmed3f(a, -126.f, 126.f);
      float e = ex2(-z);
      float lb = -lg2(1.f + e);
      float xi = lb - z;
      if (need_mask) {
        bool valid = (ci < dl);
        xi = valid ? xi : 0.f;
        lb = valid ? lb : -INFINITY;
      }
      x[16 * t + i] = xi;
      if (t) s1[i] = lb; else s0[i] = lb;
    }
  float gs[8], pg[8], pr[8];
#pragma unroll
  for (int g = 0; g < 8; ++g) {
    gs[g] = (x[4 * g] + x[4 * g + 1]) + (x[4 * g + 2] + x[4 * g + 3]);
    pg[g] = shx(gs[g], r + 32 * h);
    pr[g] = gs[g] + pg[g];
  }
  float suf = 0.f;
#pragma unroll
  for (int g = 7; g >= 0; --g) {
    float base = R + suf + (h == 0 ? pg[g] : 0.f);
    float t3 = base, t2 = t3 + x[4 * g + 3], t1 = t2 + x[4 * g + 2], t0 = t1 + x[4 * g + 1];
    const int i = 4 * (g & 3);
    if (g >= 4) {
      s1[i] = ex2(s1[i] + t0); s1[i + 1] = ex2(s1[i + 1] + t1); s1[i + 2] = ex2(s1[i + 2] + t2); s1[i + 3] = ex2(s1[i + 3] + t3);
    } else {
      s0[i] = ex2(s0[i] + t0); s0[i + 1] = ex2(s0[i + 1] + t1); s0[i + 2] = ex2(s0[i + 2] + t2); s0[i + 3] = ex2(s0[i + 3] + t3);
    }
    suf += pr[g];
  }
  R += suf;
#pragma unroll
  for (int kk = 0; kk < 4; ++kk) {
    const int s = kk & 1;
    unsigned u0, u1, u2, u3;
    if (kk < 2) {
      u0 = pk2(s0[8 * s], s0[8 * s + 1]); u1 = pk2(s0[8 * s + 2], s0[8 * s + 3]);
      u2 = pk2(s0[8 * s + 4], s0[8 * s + 5]); u3 = pk2(s0[8 * s + 6], s0[8 * s + 7]);
    } else {
      u0 = pk2(s1[8 * s], s1[8 * s + 1]); u1 = pk2(s1[8 * s + 2], s1[8 * s + 3]);
      u2 = pk2(s1[8 * s + 4], s1[8 * s + 5]); u3 = pk2(s1[8 * s + 6], s1[8 * s + 7]);
    }
    u32x4 uu = {u0, u1, u2, u3};
    bf16x8 pf = __builtin_bit_cast(bf16x8, uu);
    bf16x8 v0 = ldsv(Vs + r * LSTR + kk * 16 + 8 * h);
    bf16x8 v1 = ldsv(Vs + (32 + r) * LSTR + kk * 16 + 8 * h);
    o0 = mfma(v0, pf, o0);
    o1 = mfma(v1, pf, o1);
  }
}

DI void load_gate_rows(u32x2 (&gv)[8], const u16* grow0, int lane) {
#pragma unroll
  for (int t = 0; t < 8; ++t) gv[t] = __builtin_nontemporal_load((const u32x2*)(grow0 + (size_t)((lane >> 4) + 4 * t) * DIN + (lane & 15) * 4));
}
DI void store_y(const f32x16& oa, const f32x16& ob, float mult, const float* sg, const u32x2 (&gv)[8], u16* yrow0, float* stg,
                int lane, int r, int h) {
#pragma unroll
  for (int dt = 0; dt < 2; ++dt)
#pragma unroll
    for (int g = 0; g < 4; ++g) {
      f32x4 v;
      v[0] = (dt ? ob[4 * g] : oa[4 * g]) * mult; v[1] = (dt ? ob[4 * g + 1] : oa[4 * g + 1]) * mult;
      v[2] = (dt ? ob[4 * g + 2] : oa[4 * g + 2]) * mult; v[3] = (dt ? ob[4 * g + 3] : oa[4 * g + 3]) * mult;
      *(f32x4*)(stg + r * 68 + 32 * dt + 8 * g + 4 * h) = v;
    }
  const int kc = lane & 15;
  f32x4 sv = {1.f, 1.f, 1.f, 1.f};
  if (sg) sv = *(const f32x4*)(sg + kc * 4);
#pragma unroll
  for (int t = 0; t < 8; ++t) {
    const int row = (lane >> 4) + 4 * t;
    const f32x4 v = *(const f32x4*)(stg + row * 68 + kc * 4);
    float y0 = v[0] * sv[0] * silu(bflo(gv[t][0]));
    float y1 = v[1] * sv[1] * silu(bfhi(gv[t][0]));
    float y2 = v[2] * sv[2] * silu(bflo(gv[t][1]));
    float y3 = v[3] * sv[3] * silu(bfhi(gv[t][1]));
    u32x2 yo = {pk2(y0, y1), pk2(y2, y3)};
    *(u32x2*)(yrow0 + (size_t)row * DM + kc * 4) = yo;
  }
}

DI void attn_item_A(const Params& p, int layer, int b, int head, int qb, u16* sm, float lam, float lam_init, int wv) {
  const int tid = tid_now(wv), lane = tid & 63, w = tid >> 6, r = lane & 31, h = lane >> 5;
  const int qsub = w & 1, kh = w >> 1;
  const int q0 = qb * 64, q0w = q0 + 32 * qsub, qpos = q0w + r;
  const int qoff = head * 64, koff = 256 + head * 64, vh = head, goff = 768 + head * 64, yoff = head * 64;
  const u16* projb = p.proj + (size_t)b * SEQ * DIN;
  u16* Kb0 = sm + kh * (4 * 64 * 64);

  bf16x8 qf[4];
#pragma unroll
  for (int ks = 0; ks < 4; ++ks) qf[ks] = __builtin_nontemporal_load((const bf16x8*)(projb + (size_t)qpos * DIN + qoff + 16 * ks + 8 * h));
  const float sl2 = exp2f(-8.f * (float)(9 + head) / 12.f) * LOG2E;
  int lo[4];
#pragma unroll
  for (int c = 0; c < 4; ++c) lo[c] = r * 64 + (((2 * c + h) ^ ((r >> 1) & 7)) * 8);

  const int t7 = tid & 127, wp = t7 >> 6;
  const int csrc = (lane & 7) ^ ((4 * wp + (lane >> 4)) & 7);
  const int row0 = wp * 8 + (lane >> 3);
  const u16* kg = projb + koff + csrc * 8;
  const u16* vg = p.vt + ((size_t)(b * NVH + vh) * 64) * SEQ + csrc * 8;

  float zf = 0.f;
  asm volatile("" : "+v"(zf));
  f32x16 o[2][2];
#pragma unroll
  for (int a = 0; a < 2; ++a)
#pragma unroll
    for (int d = 0; d < 2; ++d)
#pragma unroll
      for (int e = 0; e < 16; ++e) o[a][d][e] = zf;
  float m0 = 0.f, m1 = 0.f;
  f32x4 ls0 = {zf, zf, zf, zf}, ls1 = {zf, zf, zf, zf};
  const bf16x8 ones = rowsum_ones(lane);
  bool started = false;

  const int npairs = (qb >> 1) + 1;
  const int T0 = 2 * (npairs - 1) + kh;
  const bool v0 = (T0 <= qb);
  auto dma_tile = [&](int T, int c) {
    const int k0 = 64 * T;
    u16* Kd = Kb0 + c * (2 * 64 * 64) + wp * (8 * 64);
#pragma unroll
    for (int i = 0; i < 4; ++i) {
      __builtin_amdgcn_global_load_lds((const unsigned*)(kg + (size_t)(k0 + row0 + 16 * i) * DIN), (unsigned*)(Kd + i * 16 * 64), 16, 0, 0);
      __builtin_amdgcn_global_load_lds((const unsigned*)(vg + (size_t)(row0 + 16 * i) * SEQ + k0), (unsigned*)(Kd + 64 * 64 + i * 16 * 64), 16, 0, 0);
    }
  };
  if (v0) dma_tile(T0, 0);
  asm volatile("" :: "v"(qf[0]), "v"(qf[1]), "v"(qf[2]), "v"(qf[3]));
  asm volatile("s_waitcnt vmcnt(0)" ::: "memory");
  __syncthreads();
  for (int j = 0; j < npairs; ++j) {
    if (j + 1 < npairs) dma_tile(T0 - 2 * (j + 1), (j + 1) & 1);
    if (j > 0 || v0) {
      const int T = T0 - 2 * j;
      const u16* Ks = Kb0 + (j & 1) * (2 * 64 * 64);
      const u16* Vs = Ks + 64 * 64;
      const int k0 = 64 * T;
      const bool need_mask = (T == qb);
      const int dl = qpos - k0 - 4 * h;
      diff_softmax_pv(qf, Ks, Vs, m0, ls0, ls1, ones, o, sl2, dl, need_mask, !started, r, h, 64, lo);
      m1 = m0;
      started = true;
    }
    asm volatile("s_waitcnt vmcnt(0)" ::: "memory");
    __syncthreads();
  }

  if (!started) { m0 = -INFINITY; m1 = -INFINITY; }
  float l0 = own_rowsum(ls0, r), l1 = own_rowsum(ls1, r);
  u32x2 gate[8];
  if (kh == 0) load_gate_rows(gate, projb + (size_t)q0w * DIN + goff, lane);
  float* cb = (float*)sm + (size_t)qsub * 68 * 64 + lane;
  if (kh == 1) {
#pragma unroll
    for (int a = 0; a < 2; ++a)
#pragma unroll
      for (int d = 0; d < 2; ++d)
#pragma unroll
        for (int e = 0; e < 16; ++e) cb[((a * 2 + d) * 16 + e) * 64] = o[a][d][e];
    cb[64 * 64] = m0; cb[65 * 64] = l0; cb[66 * 64] = m1; cb[67 * 64] = l1;
  }
  __syncthreads();
  if (kh == 0) {
    {
      const float mb = cb[64 * 64], lb = cb[65 * 64];
      const float mn = fmaxf(m0, mb), fa = ex2(m0 - mn), fb = ex2(mb - mn);
      l0 = l0 * fa + lb * fb;
#pragma unroll
      for (int d = 0; d < 2; ++d)
#pragma unroll
        for (int e = 0; e < 16; ++e) o[0][d][e] = o[0][d][e] * fa + cb[((0 * 2 + d) * 16 + e) * 64] * fb;
    }
    {
      const float mb = cb[66 * 64], lb = cb[67 * 64];
      const float mn = fmaxf(m1, mb), fa = ex2(m1 - mn), fb = ex2(mb - mn);
      l1 = l1 * fa + lb * fb;
#pragma unroll
      for (int d = 0; d < 2; ++d)
#pragma unroll
        for (int e = 0; e < 16; ++e) o[1][d][e] = o[1][d][e] * fa + cb[((1 * 2 + d) * 16 + e) * 64] * fb;
    }
    const float inv0 = 1.f / l0, inv1 = lam / l1;
    float sq = 0.f;
#pragma unroll
    for (int dt = 0; dt < 2; ++dt)
#pragma unroll
      for (int e = 0; e < 16; ++e) {
        float v = o[0][dt][e] * inv0 - o[1][dt][e] * inv1;
        o[0][dt][e] = v;
        sq += v * v;
      }
    sq += shx(sq, lane);
    const float mult = __builtin_amdgcn_rsqf(sq * (1.f / 64.f) + EPS) * (1.f - lam_init);
    store_y(o[0][0], o[0][1], mult, p.subln_g + layer * 64, gate,
            p.y + ((size_t)b * SEQ + q0w) * DM + yoff, (float*)sm + 9216 + w * 2176, lane, r, h);
  }
}

template <int MODE>
DI void attn_item(const Params& p, int layer, int b, int head, int qblk, u16* sm, volatile LAS int* s_done_, int wv) {
  const int tid = tid_now(wv), lane = tid & 63, w = tid >> 6, r = lane & 31, h = lane >> 5;
  const int q0 = qblk * 128, q0w = q0 + 32 * w, qpos = q0w + r;
  int qoff, koff, vh, goff, yoff;
  if (MODE == 1) { qoff = 1024 + head * 64; koff = 1536 + (head >> 2) * 64; vh = 4 + (head >> 2); goff = 1792 + head * 64; yoff = 256 + head * 64; }
  else { qoff = 2304 + head * 64; koff = 2560 + head * 64; vh = 6 + head; goff = 3072 + head * 64; yoff = 768 + head * 64; }
  const u16* projb = p.proj + (size_t)b * SEQ * DIN;
  u16* Ks = sm;
  u16* Vs = sm + 64 * LSTR;

  bf16x8 qf[4];
#pragma unroll
  for (int ks = 0; ks < 4; ++ks) qf[ks] = __builtin_nontemporal_load((const bf16x8*)(projb + (size_t)qpos * DIN + qoff + 16 * ks + 8 * h));

  float sl2 = 0.f;
  if (MODE == 1) sl2 = exp2f(-8.f * (float)(1 + head) / 12.f) * LOG2E;
  int lo[4];
#pragma unroll
  for (int c = 0; c < 4; ++c) lo[c] = r * LSTR + c * 16 + 8 * h;

  int it0 = 0, ntiles;
  if (MODE == 1) { ntiles = 4; it0 = (qblk == 0) ? 2 : 0; }
  else ntiles = 2 * (qblk + 1);

  const u16* kg = projb + koff + (tid & 7) * 8;
  const u16* vg = p.vt + ((size_t)(b * NVH + vh) * 64) * SEQ + (tid & 7) * 8;
  const int row0 = tid >> 3;
  const int loff = row0 * LSTR + (tid & 7) * 8;

  f32x16 o[2];
#pragma unroll
  for (int d = 0; d < 2; ++d)
#pragma unroll
    for (int e = 0; e < 16; ++e) o[d][e] = 0.f;
  float m0 = -INFINITY, R = 0.f;
  f32x16 ls0;
#pragma unroll
  for (int e = 0; e < 16; ++e) ls0[e] = (MODE == 1) ? 1.f : 0.f;
  if (MODE == 1) m0 = p.sinks[layer * 8 + head] * LOG2E;
  int wdone = 0;
  volatile LAS int* s_done = lds_fresh(s_done_);
  if (MODE == 2 && lane == 0) s_done[w] = 0;

  auto tile_k0 = [&](int it) -> int {
    if (MODE == 1) return q0 - 128 + 64 * it;
    return 64 * (ntiles - 1 - it);
  };
  u32x2 gate[8];
  load_gate_rows(gate, projb + (size_t)q0w * DIN + goff, lane);
  bool stop = false;
  for (int base = 0; base < ntiles && !stop; base += 4) {
    u32x4 rk[4][2], rv[4][2];
#pragma unroll
    for (int c = 0; c < 4; ++c) {
      const int it = base + c;
      if (it >= it0 && it < ntiles) {
        const int k0 = tile_k0(it);
#pragma unroll
        for (int i = 0; i < 2; ++i) {
          rk[c][i] = *(const u32x4*)(kg + (size_t)(k0 + row0 + 32 * i) * DIN);
          rv[c][i] = *(const u32x4*)(vg + (size_t)(row0 + 32 * i) * SEQ + k0);
        }
      }
    }
    __syncthreads();
    if (MODE == 2 && base > 0 && (s_done[0] & s_done[1] & s_done[2] & s_done[3])) { stop = true; }
    if (!stop) {
#pragma unroll
      for (int c = 0; c < 4; ++c) {
        const int it = base + c;
        if (it >= it0 && it < ntiles) {
#pragma unroll
          for (int i = 0; i < 2; ++i) {
            *(u32x4*)(Ks + c * (2 * 64 * LSTR) + loff + i * 32 * LSTR) = rk[c][i];
            *(u32x4*)(Vs + c * (2 * 64 * LSTR) + loff + i * 32 * LSTR) = rv[c][i];
          }
        }
      }
    }
    __syncthreads();
    if (!stop) {
#pragma unroll
      for (int c = 0; c < 4; ++c) {
        const int it = base + c;
        if (it >= it0 && it < ntiles) {
          const u16* Kc = Ks + c * (2 * 64 * LSTR);
          const u16* Vc = Vs + c * (2 * 64 * LSTR);
          const int k0 = tile_k0(it);
          bool skip, need_mask;
          if (MODE == 1) { skip = (k0 > q0w + 31) || (k0 + 63 < q0w - 127); need_mask = true; }
          else { skip = (k0 >= q0w + 31) || wdone; need_mask = (k0 + 63 >= q0w); }
          if (!skip) {
            const int dl = qpos - k0 - 4 * h;
            if (MODE == 1) {
              softmax_pv<1, 0, 4>(qf, Kc, Vc, m0, ls0, o[0], o[1], sl2, dl, need_mask, false, r, h, LSTR, lo);
            } else {
              f32x16 sa[2];
#pragma unroll
              for (int e = 0; e < 16; ++e) { sa[0][e] = 0.f; sa[1][e] = 0.f; }
#pragma unroll
              for (int t = 0; t < 2; ++t)
#pragma unroll
                for (int ks = 0; ks < 4; ++ks) {
                  bf16x8 kf = ldsv(Kc + (32 * t + r) * LSTR + ks * 16 + 8 * h);
                  sa[t] = mfma(kf, qf[ks], sa[t]);
                }
              stick_pv(sa[0], sa[1], R, o[0], o[1], Vc, dl, need_mask, r, h);
              wdone = __all(R < -160.f) ? 1 : 0;
            }
          }
        }
      }
      if (MODE == 2 && lane == 0) s_done[w] = wdone;
    }
  }
  __syncthreads();

  float inv = 1.f;
  if (MODE == 1) inv = 1.f / ls0[0];
  store_y(o[0], o[1], inv, nullptr, gate, p.y + ((size_t)b * SEQ + q0w) * DM + yoff,
          (float*)sm + 9216 + w * 2176, lane, r, h);
}

DI void attn_item_B2(const Params& p, int layer, int b, int head0, int qblk, u16* sm, int wv) {
  asm volatile("" : "+s"(head0));
  const int tid = tid_now(wv), lane = tid & 63, w = tid >> 6, r = lane & 31, h = lane >> 5;
  const int q0 = qblk * 128, q0w = q0 + 32 * w, qpos = q0w + r;
  const int koff = 1536 + (head0 >> 2) * 64, vh = 4 + (head0 >> 2);
  const u16* projb = p.proj + (size_t)b * SEQ * DIN;
  u16* Ks = sm;
  u16* Vs = sm + 64 * LSTR;
  const int it0 = (qblk == 0) ? 2 : 0;

  bf16x8 qf[2][4];
  u32x2 gate[2][8];
#pragma unroll
  for (int hh = 0; hh < 2; ++hh) {
#pragma unroll
    for (int ks = 0; ks < 4; ++ks)
      qf[hh][ks] = __builtin_nontemporal_load((const bf16x8*)(projb + (size_t)qpos * DIN + 1024 + (head0 + hh) * 64 + 16 * ks + 8 * h));
    load_gate_rows(gate[hh], projb + (size_t)q0w * DIN + 1792 + (head0 + hh) * 64, lane);
  }
  int lo[4];
#pragma unroll
  for (int c = 0; c < 4; ++c) lo[c] = r * LSTR + c * 16 + 8 * h;

  const u16* kg = projb + koff + (tid & 7) * 8;
  const u16* vg = p.vt + ((size_t)(b * NVH + vh) * 64) * SEQ + (tid & 7) * 8;
  const int row0 = tid >> 3;
  const int loff = row0 * LSTR + (tid & 7) * 8;
  {
    u32x4 rk[4][2], rv[4][2];
#pragma unroll
    for (int c = 0; c < 4; ++c) {
      if (c >= it0) {
        const int k0 = q0 - 128 + 64 * c;
#pragma unroll
        for (int i = 0; i < 2; ++i) {
          rk[c][i] = *(const u32x4*)(kg + (size_t)(k0 + row0 + 32 * i) * DIN);
          rv[c][i] = *(const u32x4*)(vg + (size_t)(row0 + 32 * i) * SEQ + k0);
        }
      }
    }
    __syncthreads();
#pragma unroll
    for (int c = 0; c < 4; ++c) {
      if (c >= it0) {
#pragma unroll
        for (int i = 0; i < 2; ++i) {
          *(u32x4*)(Ks + c * (2 * 64 * LSTR) + loff + i * 32 * LSTR) = rk[c][i];
          *(u32x4*)(Vs + c * (2 * 64 * LSTR) + loff + i * 32 * LSTR) = rv[c][i];
        }
      }
    }
    __syncthreads();
  }
  float zf = 0.f, onef = 1.f;
  asm volatile("" : "+v"(zf), "+v"(onef));
  f32x16 o[2][2], ls[2];
  float mref[2];
#pragma unroll
  for (int hh = 0; hh < 2; ++hh) {
    const int head = head0 + hh;
    const float sl2 = exp2f(-8.f * (float)(1 + head) / 12.f) * LOG2E;
#pragma unroll
    for (int e = 0; e < 16; ++e) { o[hh][0][e] = zf; o[hh][1][e] = zf; ls[hh][e] = onef; }
    mref[hh] = p.sinks[layer * 8 + head] * LOG2E;
#pragma unroll
    for (int c = 0; c < 4; ++c) {
      if (c >= it0) {
        const int k0 = q0 - 128 + 64 * c;
        const bool skip = (k0 > q0w + 31) || (k0 + 63 < q0w - 127);
        if (!skip) {
          const int dl = qpos - k0 - 4 * h;
          softmax_pv<1, 0, 4>(qf[hh], Ks + c * (2 * 64 * LSTR), Vs + c * (2 * 64 * LSTR), mref[hh], ls[hh], o[hh][0], o[hh][1],
                              sl2, dl, true, false, r, h, LSTR, lo);
        }
      }
    }
  }
  __syncthreads();
#pragma unroll
  for (int hh = 0; hh < 2; ++hh)
    store_y(o[hh][0], o[hh][1], 1.f / ls[hh][0], nullptr, gate[hh], p.y + ((size_t)b * SEQ + q0w) * DM + 256 + (head0 + hh) * 64,
            (float*)sm + 9216 + w * 2176, lane, r, h);
}

__global__ void __launch_bounds__(256, 2) hymba_mega(Params p) {
  cg::grid_group grid = cg::this_grid();
  __shared__ __attribute__((aligned(16))) u16 sm[SMEM_U16];
  __shared__ int s_item;
  __shared__ int s_done[4];
  const int wv = __builtin_amdgcn_readfirstlane((int)threadIdx.x >> 6);
  const int bid = blockIdx.x, nb = gridDim.x;
  const int xcd = bid & 7, lb = bid >> 3, nxb = nb >> 3;
  __shared__ __attribute__((aligned(16))) unsigned xb_words[4];
  if (tid_now(wv) == 0) { xb_words[0] = 0u; xb_words[1] = 0u; xb_words[2] = 0u; xb_words[3] = 0u; }
  __syncthreads();
  const XcdBarrier gb = xcd_barrier_post(p.bar, (volatile LAS unsigned*)xb_words, wv);
  if (p.never) grid.sync();

  for (int rep = 0; rep < REP_PREP; ++rep) { phase_prep(p, sm, wv); xcd_barrier(gb); }

  for (int layer = 0; layer < DEPTH; ++layer) {
    for (int rep = 0; rep < REP_G0; ++rep) {
      for (int u = lb; u < 8 * 26; u += nxb) gemm_tile<0>(p, layer, xcd + 8 * (u & 7), u >> 3, sm, wv);
      xcd_barrier(gb);
    }

    {
      const float lam_init = 0.8f - 0.6f * expf(-0.3f * (float)layer);
      float d1 = 0.f, d2 = 0.f;
      for (int i = 0; i < 32; ++i) {
        d1 += p.lq1[layer * 32 + i] * p.lk1[layer * 32 + i];
        d2 += p.lq2[layer * 32 + i] * p.lk2[layer * 32 + i];
      }
      const float lam = expf(d1) - expf(d2) + lam_init;
      for (int rep = 0; rep < REP_ATT; ++rep) {
      if (rep) xcd_barrier(gb);
      unsigned* qctr = p.ctr + (rep * 2 + layer) * 8 + xcd;
      for (;;) {
        __syncthreads();
        volatile LAS int* sit = lds_fresh((volatile LAS int*)&s_item);
        if (tid_now(wv) == 0) *sit = (int)atomicAdd(qctr, 1u);
        __syncthreads();
        const int item = *sit;
        if (item >= N_ITEMS_XCD) break;
        const int slot = (item < 128) ? 0 : (item < 192) ? 1 : 3, per = (item < 128) ? 0 : (item < 192) ? item - 128 : item - 192;
        if (slot == 0 || slot == 2) {
          const int ia = item;
          if (!(rep && (0 < REP_LO || 128 > REP_HI)))
          attn_item_A(p, layer, xcd >> 2, xcd & 3, 127 - ia, sm, lam, lam_init, wv);
        } else if (slot == 1) {
          if (!(rep && (128 < REP_LO || 192 > REP_HI)))
          attn_item_B2(p, layer, (2 * xcd) >> 3, (2 * xcd) & 7, 63 - per, sm, wv);
        } else {
          if (!(rep && (192 < REP_LO || 256 > REP_HI)))
          attn_item<2>(p, layer, xcd >> 2, xcd & 3, 63 - per, sm, (volatile LAS int*)s_done, wv);
        }
      }
      }
    }
    xcd_barrier(gb);

    for (int u = lb; u < 8 * 8; u += nxb) gemm_tile<1>(p, layer, xcd + 8 * (u & 7), u >> 3, sm, wv);
    xcd_barrier(gb);
  }

  {
    const int tid = tid_now(wv), lane = tid & 63;
    const float* ssf = p.ss + (size_t)DEPTH * MTOK;
    f32x4 gv[4];
#pragma unroll
    for (int j = 0; j < 4; ++j) gv[j] = *(const f32x4*)(p.final_g + j * 256 + lane * 4);
    for (int row0 = (bid * 4 + (tid >> 6)) * 4; row0 < MTOK; row0 += nb * 16) {
      f32x4 xv[4][4];
      float rs[4];
#pragma unroll
      for (int q = 0; q < 4; ++q) {
        rs[q] = ssf[row0 + q];
#pragma unroll
        for (int j = 0; j < 4; ++j) {
          const u32x2 xb = __builtin_nontemporal_load((const u32x2*)((const u16*)p.x2 + (size_t)(row0 + q) * DM + j * 256 + lane * 4));
          xv[q][j][0] = bflo(xb[0]); xv[q][j][1] = bfhi(xb[0]); xv[q][j][2] = bflo(xb[1]); xv[q][j][3] = bfhi(xb[1]);
        }
      }
#pragma unroll
      for (int q = 0; q < 4; ++q) {
        const float rq = __builtin_amdgcn_rsqf(rs[q] * (1.f / DM) + EPS);
#pragma unroll
        for (int j = 0; j < 4; ++j) {
          f32x4 v = xv[q][j];
          v[0] *= rq * gv[j][0]; v[1] *= rq * gv[j][1]; v[2] *= rq * gv[j][2]; v[3] *= rq * gv[j][3];
          __builtin_nontemporal_store(v, (f32x4*)(p.out + (size_t)(row0 + q) * DM + j * 256 + lane * 4));
        }
      }
    }
  }
}

extern "C" void kernel_launch(void* const* d_in, const int* in_sizes, int n_in, void* d_out, int out_size, void* d_ws,
                              size_t ws_size, hipStream_t stream) {
  static int grid_blocks = 0;
  if (!grid_blocks) {
    int dev = 0, cus = 0, per_cu = 0;
    hipGetDevice(&dev);
    hipDeviceGetAttribute(&cus, hipDeviceAttributeMultiprocessorCount, dev);
    hipOccupancyMaxActiveBlocksPerMultiprocessor(&per_cu, hymba_mega, 256, 0);
    if (per_cu > 2) per_cu = 2;
    if (per_cu < 1) per_cu = 1;
    grid_blocks = cus * per_cu;
    grid_blocks -= grid_blocks % 8;
  }
  Params p{};
  p.x = (const float*)d_in[0]; p.norm_g = (const float*)d_in[1]; p.w_in = (const float*)d_in[2];
  p.lq1 = (const float*)d_in[3]; p.lk1 = (const float*)d_in[4]; p.lq2 = (const float*)d_in[5];
  p.lk2 = (const float*)d_in[6]; p.subln_g = (const float*)d_in[7]; p.sinks = (const float*)d_in[8];
  p.w_out = (const float*)d_in[9]; p.final_g = (const float*)d_in[10];
  p.out = (float*)d_out;
  char* ws = (char*)d_ws;
  size_t off = 0;
  auto take = [&](size_t bytes) { char* q = ws + off; off += (bytes + 255) & ~(size_t)255; return q; };
  p.wtin = (u16*)take((size_t)DEPTH * DIN * 1024 * 2);
  p.wtout = (u16*)take((size_t)DEPTH * 1024 * 1024 * 2);
  p.xg = (u16*)take((size_t)MTOK * DM * 2);
  p.proj = (u16*)take((size_t)MTOK * DIN * 2);
  p.vt = (u16*)take((size_t)NBATCH * NVH * 64 * SEQ * 2);
  p.y = (u16*)take((size_t)MTOK * DM * 2);
  p.ss = (float*)take((size_t)3 * MTOK * 4);
  p.ctr = (unsigned*)take(256);
  p.bar = (unsigned*)take((size_t)XCD_BAR_WORDS * 4);
  p.x2 = (float*)p.proj;
  p.never = 0;
  (void)hipMemsetAsync(p.bar, 0, (size_t)XCD_BAR_WORDS * 4, stream);
  void* args[] = {&p};
  hipError_t e = hipLaunchCooperativeKernel((void*)hymba_mega, dim3(grid_blocks), dim3(256), args, 0, stream);
  if (e != hipSuccess) fprintf(stderr, "cooperative launch failed: %s (grid %d)\n", hipGetErrorString(e), grid_blocks);
}
```

```cpp
#include <hip/hip_runtime.h>
#include <hip/hip_cooperative_groups.h>
#include <cstdio>
namespace cg = cooperative_groups;

#define DI __device__ __forceinline__
#define LAS __attribute__((address_space(3)))
typedef unsigned short u16;
typedef __attribute__((ext_vector_type(8))) __bf16 bf16x8;
typedef __attribute__((ext_vector_type(2))) __bf16 bf16x2;
typedef __attribute__((ext_vector_type(16))) float f32x16;
typedef __attribute__((ext_vector_type(2))) float f32x2;
typedef __attribute__((ext_vector_type(4))) unsigned u32x4;
typedef __attribute__((ext_vector_type(2))) unsigned u32x2;
typedef __attribute__((ext_vector_type(4))) float f32x4;

constexpr int SEQ = 8192, NBATCH = 2, DM = 1024, MTOK = NBATCH * SEQ, DIN = 3328, DEPTH = 2, NVH = 10;
constexpr float EPS = 1e-5f, LOG2E = 1.4426950408889634f;
constexpr int LSTR = 72;
constexpr int SMEM_U16 = 8 * 64 * LSTR;
constexpr int N_ITEMS_XCD = 128 + 64 + 64;
#ifndef REP_PREP
#define REP_PREP 1
#endif
#ifndef REP_G0
#define REP_G0 1
#endif
#ifndef REP_ATT
#define REP_ATT 1
#endif
#ifndef REP_LO
#define REP_LO 0
#endif
#ifndef REP_HI
#define REP_HI N_ITEMS_XCD
#endif

struct Params {
  const float *x, *norm_g, *w_in, *lq1, *lk1, *lq2, *lk2, *subln_g, *sinks, *w_out, *final_g;
  float* out;
  u16* wtin;
  u16* wtout;
  u16* xg;
  u16* proj;
  u16* vt;
  u16* y;
  float* ss;
  unsigned* ctr;
  unsigned* bar;
  float* x2;
  size_t never;
};

DI unsigned pk2(float a, float b) {
  f32x2 v = {a, b};
  bf16x2 r = __builtin_convertvector(v, bf16x2);
  return __builtin_bit_cast(unsigned, r);
}
DI uint2 pk4(float a, float b, float c, float d) { uint2 r; r.x = pk2(a, b); r.y = pk2(c, d); return r; }
DI float bflo(unsigned v) { return __uint_as_float(v << 16); }
DI float bfhi(unsigned v) { return __uint_as_float(v & 0xffff0000u); }
DI float ex2(float x) { return __builtin_amdgcn_exp2f(x); }

DI float lg2(float x) { return __builtin_amdgcn_logf(x); }
DI f32x16 mfma(bf16x8 a, bf16x8 b, f32x16 c) { return __builtin_amdgcn_mfma_f32_32x32x16_bf16(a, b, c, 0, 0, 0); }
DI bf16x8 ldsv(const u16* p) { return *(const bf16x8*)p; }
DI float silu(float g) { return g * __builtin_amdgcn_rcpf(1.f + ex2(-g * LOG2E)); }
DI int tid_now(int wv) {
  int t;
  asm volatile("v_mbcnt_lo_u32_b32 %0, -1, 0\n\tv_mbcnt_hi_u32_b32 %0, -1, %0" : "=v"(t));
  return wv * 64 + t;
}
DI float shx(float v, int lane, int o = 32) {
  return __int_as_float(__builtin_amdgcn_ds_bpermute((lane ^ o) << 2, __float_as_int(v)));
}
template <typename T> DI volatile LAS T* lds_fresh(volatile LAS T* q) { asm volatile("" : "+v"(q)); return q; }
DI float wave_sum(float v, int lane) {
#pragma unroll
  for (int o = 32; o >= 1; o >>= 1) v += shx(v, lane, o);
  return v;
}


#define XB_TMO      128
#define XB_XCNT(j)  (256  + 64 * (j))
#define XB_XSUB(j)  (1280 + 64 * (j))
#define XB_XGEN(j)  (2304 + 64 * (j))
#define XB_TOP      3328
#define XB_TOPGEN   3392
#define XCD_BAR_WORDS 3456
#define XB_SPIN_CAP (1u << 18)
DI unsigned xb_ld(unsigned* p) { return __hip_atomic_load(p, __ATOMIC_RELAXED, __HIP_MEMORY_SCOPE_AGENT); }
DI unsigned xb_add(unsigned* p, unsigned v) { return __hip_atomic_fetch_add(p, v, __ATOMIC_RELAXED, __HIP_MEMORY_SCOPE_AGENT); }
DI unsigned xb_xcc_id() { return (unsigned)__builtin_amdgcn_s_getreg((3 << 11) | 20) & 0xFu; }
#define XB_SPIN(cond, bar) do { unsigned _sp = 0; while (cond) { __builtin_amdgcn_s_sleep(1); \
    if ((++_sp & 255u) == 0u) { if (xb_ld(&(bar)[XB_TMO])) break; if (_sp > XB_SPIN_CAP) { atomicAdd(&(bar)[XB_TMO], 1u); break; } } } } while (0)
struct XcdBarrier { unsigned* bar; unsigned x; volatile LAS unsigned* st; int wv; };
DI XcdBarrier xcd_barrier_post(unsigned* bar, volatile LAS unsigned* st, int wv) {
  XcdBarrier b; b.bar = bar; b.x = xb_xcc_id(); b.st = st; b.wv = wv;
  if (tid_now(wv) == 0) (void)xb_add(&bar[XB_XCNT(b.x)], 1u);
  return b;
}
DI void xcd_barrier_complete(unsigned* bar, unsigned x, unsigned& nloc, unsigned& nx) {
  const unsigned G = gridDim.x * gridDim.y * gridDim.z;
  unsigned sum, cnt, mine, sp = 0u;
  for (;;) {
    sum = 0u; cnt = 0u; mine = 0u;
#pragma unroll
    for (unsigned j = 0; j < 16; ++j) { const unsigned c = xb_ld(&bar[XB_XCNT(j)]); sum += c; cnt += (c > 0u) ? 1u : 0u; mine = (j == x) ? c : mine; }
    if (sum == G) break;
    __builtin_amdgcn_s_sleep(1);
    if ((++sp & 255u) == 0u) { if (xb_ld(&bar[XB_TMO])) break; if (sp > XB_SPIN_CAP) { atomicAdd(&bar[XB_TMO], 1u); break; } }
  }
  nloc = mine > 0u ? mine : 1u; nx = cnt > 0u ? cnt : 1u;
}
DI void xcd_barrier(const XcdBarrier& b) {
  asm volatile("s_waitcnt vmcnt(0)" ::: "memory");
  __syncthreads();
  if (tid_now(b.wv) == 0) {
    unsigned* bar = b.bar;
    __builtin_amdgcn_s_waitcnt(0);
    volatile LAS unsigned* st = lds_fresh(b.st);
    unsigned nloc = st[0], nx = st[1];
    if (nloc == 0u) { xcd_barrier_complete(bar, b.x, nloc, nx); st[0] = nloc; st[1] = nx; }
    const unsigned old = xb_add(&bar[XB_XSUB(b.x)], 1u);
    const unsigned gen = old / nloc;
    if (old + 1u == (gen + 1u) * nloc) {
      __builtin_amdgcn_fence(__ATOMIC_RELEASE, "agent");
      asm volatile("s_waitcnt vmcnt(0)" ::: "memory");
      const unsigned og = xb_add(&bar[XB_TOP], 1u);
      const unsigned tg = og / nx;
      if (og + 1u == (tg + 1u) * nx) xb_add(&bar[XB_TOPGEN], 1u);
      else XB_SPIN(xb_ld(&bar[XB_TOPGEN]) == tg, bar);
      __builtin_amdgcn_fence(__ATOMIC_ACQUIRE, "agent");
      xb_add(&bar[XB_XGEN(b.x)], 1u);
      asm volatile("s_waitcnt vmcnt(0)" ::: "memory");
    } else {
      XB_SPIN(xb_ld(&bar[XB_XGEN(b.x)]) == gen, bar);
      __builtin_amdgcn_fence(__ATOMIC_ACQUIRE, "agent");
      asm volatile("s_waitcnt vmcnt(0)" ::: "memory");
    }
  }
  __syncthreads();
}

DI void phase_prep(const Params& p, u16* sm, int wv) {
  const int tid = tid_now(wv), nb = gridDim.x, bid = blockIdx.x;
  float* smf = (float*)sm;
  constexpr int T_IN = DEPTH * 16 * 52, T_OUT = DEPTH * 16 * 16;
  for (int t = bid; t < T_IN + T_OUT; t += nb) {
    const float* src; u16* dst; int N, kt, nt; const float* gsc = nullptr;
    if (t < T_IN) {
      int l = t / 832, rr = t % 832; kt = rr / 52; nt = rr % 52; N = DIN;
      src = p.w_in + (size_t)l * 1024 * DIN; dst = p.wtin + (size_t)l * DIN * 1024; gsc = p.norm_g + l * DM;
    } else {
      int u = t - T_IN; int l = u / 256, rr = u % 256; kt = rr / 16; nt = rr % 16; N = 1024;
      src = p.w_out + (size_t)l * 1024 * 1024; dst = p.wtout + (size_t)l * 1024 * 1024;
    }
    __syncthreads();
#pragma unroll
    for (int i = 0; i < 4; ++i) {
      const int k = i * 16 + (tid >> 4), n4 = (tid & 15) * 4;
      const f32x4 v = __builtin_nontemporal_load((const f32x4*)(src + (size_t)(kt * 64 + k) * N + nt * 64 + n4));
      const float gk = gsc ? gsc[kt * 64 + k] : 1.f;
      smf[(n4 + 0) * 65 + k] = v[0] * gk; smf[(n4 + 1) * 65 + k] = v[1] * gk;
      smf[(n4 + 2) * 65 + k] = v[2] * gk; smf[(n4 + 3) * 65 + k] = v[3] * gk;
    }
    __syncthreads();
#pragma unroll
    for (int j = 0; j < 2; ++j) {
      const int c = tid + 256 * j, kc = c & 7, n = c >> 3;
      const float* q = smf + n * 65 + kc * 8;
      u32x4 o = {pk2(q[0], q[1]), pk2(q[2], q[3]), pk2(q[4], q[5]), pk2(q[6], q[7])};
      *(u32x4*)(dst + (size_t)(nt * 64 + n) * 1024 + kt * 64 + kc * 8) = o;
    }
  }
  const int lane = tid & 63;
  {
    for (int row0 = (bid * 4 + (tid >> 6)) * 4; row0 < MTOK; row0 += nb * 16) {
      f32x4 xv[4][4];
#pragma unroll
      for (int q = 0; q < 4; ++q)
#pragma unroll
        for (int j = 0; j < 4; ++j) xv[q][j] = __builtin_nontemporal_load((const f32x4*)(p.x + (size_t)(row0 + q) * DM + j * 256 + lane * 4));
#pragma unroll
      for (int q = 0; q < 4; ++q) {
        float sq = 0.f;
#pragma unroll
        for (int j = 0; j < 4; ++j) {
          const f32x4 v = xv[q][j];
          sq += v[0] * v[0] + v[1] * v[1] + v[2] * v[2] + v[3] * v[3];
          u32x2 o = {pk2(v[0], v[1]), pk2(v[2], v[3])};
          *(u32x2*)(p.xg + (size_t)(row0 + q) * DM + j * 256 + lane * 4) = o;
        }
        sq = wave_sum(sq, lane);
        if (lane == 0) p.ss[row0 + q] = sq;
      }
    }
  }
  for (int i = bid * 256 + tid; i < 2 * MTOK; i += nb * 256) p.ss[MTOK + i] = 0.f;
  if (bid == 0 && tid < 64) p.ctr[tid] = 0u;
}

constexpr int GSTR = 80;
DI f32x4 mfma16(bf16x8 a, bf16x8 b, f32x4 c) { return __builtin_amdgcn_mfma_f32_16x16x32_bf16(a, b, c, 0, 0, 0); }

template <bool VT>
DI void gemm_kslab(f32x4 (&acc)[8][4], const u16* sA, const u16* sB, int wm, int wn, int fr, int fq) {
#pragma unroll
  for (int ks = 0; ks < 2; ++ks) {
    bf16x8 tb[4], ta[8];
#pragma unroll
    for (int j = 0; j < 4; ++j) tb[j] = ldsv(sB + (wn * 64 + 16 * j + fr) * GSTR + ks * 32 + 8 * fq);
#pragma unroll
    for (int i = 0; i < 8; ++i) ta[i] = ldsv(sA + (wm * 128 + 16 * i + fr) * GSTR + ks * 32 + 8 * fq);
#pragma unroll
    for (int i = 0; i < 8; ++i)
#pragma unroll
      for (int j = 0; j < 4; ++j)
        acc[i][j] = VT ? mfma16(ta[i], tb[j], acc[i][j]) : mfma16(tb[j], ta[i], acc[i][j]);
  }
  __builtin_amdgcn_sched_group_barrier(0x100, 6, 0);
#pragma unroll
  for (int g = 0; g < 6; ++g) {
    __builtin_amdgcn_sched_group_barrier(0x008, 4, 0);
    __builtin_amdgcn_sched_group_barrier(0x100, 1, 0);
  }
  __builtin_amdgcn_sched_group_barrier(0x100, 6, 0);
  __builtin_amdgcn_sched_group_barrier(0x008, 8, 0);
#pragma unroll
  for (int g = 0; g < 6; ++g) {
    __builtin_amdgcn_sched_group_barrier(0x008, 4, 0);
    __builtin_amdgcn_sched_group_barrier(0x100, 1, 0);
  }
  __builtin_amdgcn_sched_group_barrier(0x008, 8, 0);
}

template <bool VT>
DI void gemm_mainloop(f32x4 (&acc)[8][4], const char* abase, const char* bbase, unsigned toff, u16* sA, u16* sB, int loff, int wm, int wn, int fr, int fq) {
  const __amdgpu_buffer_rsrc_t ra_rs = __builtin_amdgcn_make_buffer_rsrc((void*)abase, (short)0, 256 * 2048, 0x00020000);
  const __amdgpu_buffer_rsrc_t rb_rs = __builtin_amdgcn_make_buffer_rsrc((void*)bbase, (short)0, 128 * 2048, 0x00020000);
  u32x4 ra[8], rb[4];
#pragma unroll
  for (int i = 0; i < 8; ++i) ra[i] = __builtin_amdgcn_raw_buffer_load_b128(ra_rs, (int)toff, i * 65536, 0);
#pragma unroll
  for (int i = 0; i < 4; ++i) rb[i] = __builtin_amdgcn_raw_buffer_load_b128(rb_rs, (int)toff, i * 65536, 0);
#pragma unroll 1
  for (int kt = 0; kt < 16; ++kt) {
    __syncthreads();
#pragma unroll
    for (int i = 0; i < 8; ++i) *(u32x4*)(sA + loff + i * 32 * GSTR) = ra[i];
#pragma unroll
    for (int i = 0; i < 4; ++i) *(u32x4*)(sB + loff + i * 32 * GSTR) = rb[i];
    __syncthreads();
    if (kt + 1 < 16) {
      const int ko = (kt + 1) * 128;
#pragma unroll
      for (int i = 0; i < 8; ++i) ra[i] = __builtin_amdgcn_raw_buffer_load_b128(ra_rs, (int)toff, i * 65536 + ko, 0);
#pragma unroll
      for (int i = 0; i < 4; ++i) rb[i] = __builtin_amdgcn_raw_buffer_load_b128(rb_rs, (int)toff, i * 65536 + ko, 0);
    }
    __builtin_amdgcn_s_setprio(1);
    gemm_kslab<VT>(acc, sA, sB, wm, wn, fr, fq);
    __builtin_amdgcn_s_setprio(0);
  }
}

template <int EPI>
DI void gemm_tile(const Params& p, int layer, int mt, int nt, u16* sm, int wv) {
  const int tid = tid_now(wv), w = tid >> 6;
  int lane = tid & 63, fr = lane & 15, fq = lane >> 4;
  const u16* A = (EPI == 0) ? p.xg : p.y;
  const u16* Bt = (EPI == 0) ? p.wtin + (size_t)layer * DIN * 1024 : p.wtout + (size_t)layer * 1024 * 1024;
  const int m0 = mt * 256, n0 = nt * 128;
  const char* abase = (const char*)(A + (size_t)m0 * 1024);
  const char* bbase = (const char*)(Bt + (size_t)n0 * 1024);
  const unsigned toff = (unsigned)(tid >> 3) * 2048u + (unsigned)(tid & 7) * 16u;
  const int loff = (tid >> 3) * GSTR + (tid & 7) * 8;
  u16* sA = sm;
  u16* sB = sm + 256 * GSTR;
  f32x4 acc[8][4];
#pragma unroll
  for (int i = 0; i < 8; ++i)
#pragma unroll
    for (int j = 0; j < 4; ++j)
#pragma unroll
      for (int e = 0; e < 4; ++e) acc[i][j][e] = 0.f;

  bool vtile = false;
  if (EPI == 0) vtile = (nt == 4 || nt == 5 || nt == 13 || nt == 22 || nt == 23);
  int wm = w >> 1, wn = w & 1;

  if (EPI == 0 && vtile) { asm volatile("; v-tile main loop" ::: "memory"); gemm_mainloop<true>(acc, abase, bbase, toff, sA, sB, loff, wm, wn, fr, fq); }
  else { asm volatile("; main loop" ::: "memory"); gemm_mainloop<false>(acc, abase, bbase, toff, sA, sB, loff, wm, wn, fr, fq); }

  {
    const int t2 = tid_now(wv);
    const int l2 = t2 & 63, w2 = t2 >> 6;
    lane = l2; fr = l2 & 15; fq = l2 >> 4; wm = w2 >> 1; wn = w2 & 1;
  }
  if (EPI == 0) {
    const float* ssl = p.ss + (size_t)layer * MTOK;
    __syncthreads();
    u16* stg = sm + (wm * 2 + wn) * (128 * LSTR);
    if (!vtile) {
      const float qsc = (nt < 2) ? 0.17677669529663687f * LOG2E
                        : ((nt >= 8 && nt < 12) || nt == 18 || nt == 19) ? 0.125f * LOG2E : 1.f;
#pragma unroll
      for (int i = 0; i < 8; ++i) {
        const int m = m0 + wm * 128 + 16 * i + fr;
        const float rs = __builtin_amdgcn_rsqf(ssl[m] * (1.f / DM) + EPS) * qsc;
        u16* d = stg + (16 * i + fr) * LSTR + 4 * fq;
#pragma unroll
        for (int j = 0; j < 4; ++j) {
          u32x2 v = {pk2(acc[i][j][0] * rs, acc[i][j][1] * rs), pk2(acc[i][j][2] * rs, acc[i][j][3] * rs)};
          *(u32x2*)(d + 16 * j) = v;
        }
      }
      u16* gdst = p.proj + (size_t)(m0 + wm * 128) * DIN + n0 + wn * 64;
#pragma unroll
      for (int t = 0; t < 16; ++t) {
        const int c = lane + 64 * t, row = c >> 3, kc = c & 7;
        const u32x4 v = *(const u32x4*)(stg + row * LSTR + kc * 8);
        *(u32x4*)(gdst + (size_t)row * DIN + kc * 8) = v;
      }
    } else {
      const int vbase = (nt == 4) ? 0 : (nt == 5) ? 2 : (nt == 13) ? 4 : (nt == 22) ? 6 : 8;
      const int bb = m0 / SEQ, s0 = m0 % SEQ;
      constexpr int VSTR = 136;
#pragma unroll
      for (int i = 0; i < 8; ++i) {
        float rs[4];
#pragma unroll
        for (int e = 0; e < 4; ++e) rs[e] = __builtin_amdgcn_rsqf(ssl[m0 + wm * 128 + 16 * i + 4 * fq + e] * (1.f / DM) + EPS);
        const int pos = 16 * i + 8 * (fq & 1) + 4 * (fq >> 1);
#pragma unroll
        for (int j = 0; j < 4; ++j) {
          u32x2 v = {pk2(acc[i][j][0] * rs[0], acc[i][j][1] * rs[1]), pk2(acc[i][j][2] * rs[2], acc[i][j][3] * rs[3])};
          *(u32x2*)(stg + (16 * j + fr) * VSTR + pos) = v;
        }
      }
      u16* gdst = p.vt + ((size_t)(bb * NVH + vbase + wn) * 64) * SEQ + s0 + wm * 128;
#pragma unroll
      for (int t = 0; t < 16; ++t) {
        const int c = lane + 64 * t, row = c >> 4, kc = c & 15;
        const u32x4 v = *(const u32x4*)(stg + row * VSTR + kc * 8);
        *(u32x4*)(gdst + (size_t)row * SEQ + kc * 8) = v;
      }
    }
  } else {
    const bool has_next = (layer + 1 < DEPTH);
    float* ssn = p.ss + (size_t)(layer + 1) * MTOK;
    __syncthreads();
    float* stg = (float*)(sm + (wm * 2 + wn) * (128 * LSTR));
    const int kc = lane & 15;
#pragma unroll
    for (int hh = 0; hh < 2; ++hh) {
#pragma unroll
      for (int i2 = 0; i2 < 4; ++i2)
#pragma unroll
        for (int j = 0; j < 4; ++j)
          *(f32x4*)(stg + (16 * i2 + fr) * 68 + 16 * j + 4 * fq) = acc[4 * hh + i2][j];
      const size_t mrow0 = (size_t)(m0 + wm * 128 + 64 * hh);
      u16* xrow = p.xg + mrow0 * DM + n0 + wn * 64 + kc * 4;
      u16* x2row = (u16*)p.x2 + mrow0 * DM + n0 + wn * 64 + kc * 4;
      u32x2 xb[16];
#pragma unroll
      for (int t = 0; t < 16; ++t) xb[t] = __builtin_nontemporal_load((const u32x2*)(xrow + (size_t)((lane >> 4) + 4 * t) * DM));
#pragma unroll
      for (int t = 0; t < 16; ++t) {
        const int row = (lane >> 4) + 4 * t;
        const f32x4 a4 = *(const f32x4*)(stg + row * 68 + kc * 4);
        const float v0 = bflo(xb[t][0]) + a4[0], v1 = bfhi(xb[t][0]) + a4[1], v2 = bflo(xb[t][1]) + a4[2], v3 = bfhi(xb[t][1]) + a4[3];
        float sq = v0 * v0 + v1 * v1 + v2 * v2 + v3 * v3;
        u32x2 pv = {pk2(v0, v1), pk2(v2, v3)};
        if (has_next) *(u32x2*)(xrow + (size_t)row * DM) = pv;
        else *(u32x2*)(x2row + (size_t)row * DM) = pv;
        sq += shx(sq, lane, 1); sq += shx(sq, lane, 2); sq += shx(sq, lane, 4); sq += shx(sq, lane, 8);
        if (kc == 0) atomicAdd(ssn + mrow0 + row, sq);
      }
    }
  }
}

template <int MODE, int KS0, int NKS>
DI void qk_scores(f32x16& s0, f32x16& s1, const u16* Ks, const bf16x8 (&qf)[4], float sl2, int dl, float mref,
                  bool need_mask, int r, int h, int rs, const int (&lo)[4]) {
  asm volatile("" : "+v"(dl));
  const float nb = -sl2 * (float)dl - mref;
#pragma unroll
  for (int i = 0; i < 16; ++i) {
    const int ci = (i & 3) + 8 * (i >> 2);
    s0[i] = fmaf(sl2, (float)ci, nb);
    s1[i] = fmaf(sl2, (float)(ci + 32), nb);
  }
#pragma unroll
  for (int ks = 0; ks < NKS; ++ks) {
    bf16x8 k0 = ldsv(Ks + lo[KS0 + ks]);
    bf16x8 k1 = ldsv(Ks + 32 * rs + lo[KS0 + ks]);
    s0 = mfma(k0, qf[KS0 + ks], s0);
    s1 = mfma(k1, qf[KS0 + ks], s1);
  }
  if (need_mask) {
#pragma unroll
    for (int i = 0; i < 16; ++i) {
      const int ci = (i & 3) + 8 * (i >> 2);
      bool v0 = (MODE == 0) ? (ci <= dl) : (ci <= dl && ci > dl - 128);
      bool v1 = (MODE == 0) ? (ci + 32 <= dl) : (ci + 32 <= dl && ci + 32 > dl - 128);
      s0[i] = v0 ? s0[i] : -INFINITY;
      s1[i] = v1 ? s1[i] : -INFINITY;
    }
  }
}
template <int MODE, int KS0, int NKS>
DI void softmax_pv(const bf16x8 (&qf)[4], const u16* Ks, const u16* Vs, float& m, f32x16& ls, f32x16& o0, f32x16& o1,
                   float sl2, int dl, bool need_mask, bool first, int r, int h, int rs, const int (&lo)[4]) {
  f32x16 s0, s1;
  qk_scores<MODE, KS0, NKS>(s0, s1, Ks, qf, sl2, dl, m, need_mask, r, h, rs, lo);
  if (__any(first || !(ls[0] <= 1.0e12f))) {
    float tmax = -INFINITY;
#pragma unroll
    for (int i = 0; i < 16; ++i) tmax = fmaxf(tmax, fmaxf(s0[i], s1[i]));
    tmax = fmaxf(tmax, shx(tmax, r + 32 * h));
    const float lref = (ls[0] > 1.f) ? lg2(ls[0]) : 0.f;
    const float delta = first ? tmax : fmaxf(fmaxf(tmax, lref), 0.f);
    m += delta;
    const float alpha = ex2(-delta);
#pragma unroll
    for (int e = 0; e < 16; ++e) { o0[e] *= alpha; o1[e] *= alpha; ls[e] *= alpha; }
#pragma unroll
    for (int i = 0; i < 16; ++i) { s0[i] -= delta; s1[i] -= delta; }
  }
#pragma unroll
  for (int i = 0; i < 16; ++i) { s0[i] = ex2(s0[i]); s1[i] = ex2(s1[i]); }
  const u32x4 one4 = {0x3f803f80u, 0x3f803f80u, 0x3f803f80u, 0x3f803f80u};
  const bf16x8 ones = __builtin_bit_cast(bf16x8, one4);
#pragma unroll
  for (int kk = 0; kk < 4; ++kk) {
    const int s = kk & 1;
    unsigned u0, u1, u2, u3;
    if (kk < 2) {
      u0 = pk2(s0[8 * s], s0[8 * s + 1]); u1 = pk2(s0[8 * s + 2], s0[8 * s + 3]);
      u2 = pk2(s0[8 * s + 4], s0[8 * s + 5]); u3 = pk2(s0[8 * s + 6], s0[8 * s + 7]);
    } else {
      u0 = pk2(s1[8 * s], s1[8 * s + 1]); u1 = pk2(s1[8 * s + 2], s1[8 * s + 3]);
      u2 = pk2(s1[8 * s + 4], s1[8 * s + 5]); u3 = pk2(s1[8 * s + 6], s1[8 * s + 7]);
    }
    u32x4 uu = {u0, u1, u2, u3};
    bf16x8 pf = __builtin_bit_cast(bf16x8, uu);
    bf16x8 v0 = ldsv(Vs + lo[kk]);
    bf16x8 v1 = ldsv(Vs + 32 * rs + lo[kk]);
    o0 = mfma(v0, pf, o0);
    o1 = mfma(v1, pf, o1);
    ls = mfma(ones, pf, ls);
  }
}

DI void pv_frag_step(f32x16& s0, f32x16& s1, const u16* Vs, f32x16& o0, f32x16& o1, f32x4& ls, bf16x8 ones, int rs, const int (&lo)[4]) {
#pragma unroll
  for (int i = 0; i < 16; ++i) { s0[i] = ex2(s0[i]); s1[i] = ex2(s1[i]); }
#pragma unroll
  for (int kk = 0; kk < 4; ++kk) {
    const int s = kk & 1;
    unsigned u0, u1, u2, u3;
    if (kk < 2) {
      u0 = pk2(s0[8 * s], s0[8 * s + 1]); u1 = pk2(s0[8 * s + 2], s0[8 * s + 3]);
      u2 = pk2(s0[8 * s + 4], s0[8 * s + 5]); u3 = pk2(s0[8 * s + 6], s0[8 * s + 7]);
    } else {
      u0 = pk2(s1[8 * s], s1[8 * s + 1]); u1 = pk2(s1[8 * s + 2], s1[8 * s + 3]);
      u2 = pk2(s1[8 * s + 4], s1[8 * s + 5]); u3 = pk2(s1[8 * s + 6], s1[8 * s + 7]);
    }
    u32x4 uu = {u0, u1, u2, u3};
    bf16x8 pf = __builtin_bit_cast(bf16x8, uu);
    bf16x8 v0 = ldsv(Vs + lo[kk]);
    bf16x8 v1 = ldsv(Vs + 32 * rs + lo[kk]);
    o0 = mfma(v0, pf, o0);
    o1 = mfma(v1, pf, o1);
    ls = mfma16(ones, pf, ls);
  }
}
DI void mask_causal(f32x16& s0, f32x16& s1, int dl) {
#pragma unroll
  for (int i = 0; i < 16; ++i) {
    const int ci = (i & 3) + 8 * (i >> 2);
    s0[i] = (ci <= dl) ? s0[i] : -INFINITY;
    s1[i] = (ci + 32 <= dl) ? s1[i] : -INFINITY;
  }
}
DI float bperm(float v, int srclane) { return __int_as_float(__builtin_amdgcn_ds_bpermute(srclane << 2, __float_as_int(v))); }
DI float own_rowsum(const f32x4& ls, int r) {
  const float a = bperm(ls[0], r & 15), b = bperm(ls[1], r & 15);
  return (r >> 4) ? b : a;
}
DI bf16x8 rowsum_ones(int lane) {
  const int fr16 = lane & 15, g = lane >> 4;
  const unsigned w = (fr16 < 2 && fr16 == (g & 1)) ? 0x3f803f80u : 0u;
  const u32x4 v = {w, w, w, w};
  return __builtin_bit_cast(bf16x8, v);
}
DI void diff_softmax_pv(const bf16x8 (&qf)[4], const u16* Ks, const u16* Vs, float& m, f32x4& ls0, f32x4& ls1, bf16x8 ones,
                        f32x16 (&o)[2][2], float sl2, int dl, bool need_mask, bool first, int r, int h, int rs, const int (&lo)[4]) {
  f32x16 b0, b1;
  const float nb = -sl2 * (float)dl - m;
#pragma unroll
  for (int i = 0; i < 16; ++i) {
    const int ci = (i & 3) + 8 * (i >> 2);
    b0[i] = fmaf(sl2, (float)ci, nb);
    b1[i] = fmaf(sl2, (float)(ci + 32), nb);
  }
  {
    f32x16 s0 = mfma(ldsv(Ks + lo[0]), qf[0], b0);
    f32x16 s1 = mfma(ldsv(Ks + 32 * rs + lo[0]), qf[0], b1);
    s0 = mfma(ldsv(Ks + lo[1]), qf[1], s0);
    s1 = mfma(ldsv(Ks + 32 * rs + lo[1]), qf[1], s1);
    if (need_mask) mask_causal(s0, s1, dl);
    if (__any(first || !(ls0[0] <= 1.0e12f) || !(ls0[1] <= 1.0e12f) || !(ls1[0] <= 1.0e12f) || !(ls1[1] <= 1.0e12f))) {
      float tmax = -INFINITY;
#pragma unroll
      for (int i = 0; i < 16; ++i) tmax = fmaxf(tmax, fmaxf(s0[i], s1[i]));
      tmax = fmaxf(tmax, shx(tmax, r + 32 * h));
      const float lmx = fmaxf(own_rowsum(ls0, r), own_rowsum(ls1, r));
      const float lref = (lmx > 1.f) ? lg2(lmx) : 0.f;
      const float delta = first ? tmax : fmaxf(fmaxf(tmax, lref), 0.f);
      m += delta;
      const float alpha = ex2(-delta);
      const float alpha_hi = shx(alpha, r + 32 * h, 16);
      ls0[0] *= alpha; ls0[1] *= alpha_hi; ls1[0] *= alpha; ls1[1] *= alpha_hi;
#pragma unroll
      for (int e = 0; e < 16; ++e) {
        o[0][0][e] *= alpha; o[0][1][e] *= alpha; o[1][0][e] *= alpha; o[1][1][e] *= alpha;
        s0[e] -= delta; s1[e] -= delta; b0[e] -= delta; b1[e] -= delta;
      }
    }
    pv_frag_step(s0, s1, Vs, o[0][0], o[0][1], ls0, ones, rs, lo);
  }
  {
    f32x16 s0 = mfma(ldsv(Ks + lo[2]), qf[2], b0);
    f32x16 s1 = mfma(ldsv(Ks + 32 * rs + lo[2]), qf[2], b1);
    s0 = mfma(ldsv(Ks + lo[3]), qf[3], s0);
    s1 = mfma(ldsv(Ks + 32 * rs + lo[3]), qf[3], s1);
    if (need_mask) mask_causal(s0, s1, dl);
    pv_frag_step(s0, s1, Vs, o[1][0], o[1][1], ls1, ones, rs, lo);
  }
}

DI void stick_pv(f32x16& s0, f32x16& s1, float& R, f32x16& o0, f32x16& o1, const u16* Vs, int dl,
                 bool need_mask, int r, int h) {
  float x[32];
#pragma unroll
  for (int t = 0; t < 2; ++t)
#pragma unroll
    for (int i = 0; i < 16; ++i) {
      const int ci = 32 * t + (i & 3) + 8 * (i >> 2);
      float a = t ? s1[i] : s0[i];
      float z = __builtin_amdgcn_fmed3f(a, -126.f, 126.f);
      float e = ex2(-z);
      float lb = -lg2(1.f + e);
      float xi = lb - z;
      if (need_mask) {
        bool valid = (ci < dl);
        xi = valid ? xi : 0.f;
        lb = valid ? lb : -INFINITY;
      }
      x[16 * t + i] = xi;
      if (t) s1[i] = lb; else s0[i] = lb;
    }
  float gs[8], pg[8], pr[8];
#pragma unroll
  for (int g = 0; g < 8; ++g) {
    gs[g] = (x[4 * g] + x[4 * g + 1]) + (x[4 * g + 2] + x[4 * g + 3]);
    pg[g] = shx(gs[g], r + 32 * h);
    pr[g] = gs[g] + pg[g];
  }
  float suf = 0.f;
#pragma unroll
  for (int g = 7; g >= 0; --g) {
    float base = R + suf + (h == 0 ? pg[g] : 0.f);
    float t3 = base, t2 = t3 + x[4 * g + 3], t1 = t2 + x[4 * g + 2], t0 = t1 + x[4 * g + 1];
    const int i = 4 * (g & 3);
    if (g >= 4) {
      s1[i] = ex2(s1[i] + t0); s1[i + 1] = ex2(s1[i + 1] + t1); s1[i + 2] = ex2(s1[i + 2] + t2); s1[i + 3] = ex2(s1[i + 3] + t3);
    } else {
      s0[i] = ex2(s0[i] + t0); s0[i + 1] = ex2(s0[i + 1] + t1); s0[i + 2] = ex2(s0[i + 2] + t2); s0[i + 3] = ex2(s0[i + 3] + t3);
    }
    suf += pr[g];
  }
  R += suf;
#pragma unroll
  for (int kk = 0; kk < 4; ++kk) {
    const int s = kk & 1;
    unsigned u0, u1, u2, u3;
    if (kk < 2) {
      u0 = pk2(s0[8 * s], s0[8 * s + 1]); u1 = pk2(s0[8 * s + 2], s0[8 * s + 3]);
      u2 = pk2(s0[8 * s + 4], s0[8 * s + 5]); u3 = pk2(s0[8 * s + 6], s0[8 * s + 7]);
    } else {
      u0 = pk2(s1[8 * s], s1[8 * s + 1]); u1 = pk2(s1[8 * s + 2], s1[8 * s + 3]);
      u2 = pk2(s1[8 * s + 4], s1[8 * s + 5]); u3 = pk2(s1[8 * s + 6], s1[8 * s + 7]);
    }
    u32x4 uu = {u0, u1, u2, u3};
    bf16x8 pf = __builtin_bit_cast(bf16x8, uu);
    bf16x8 v0 = ldsv(Vs + r * LSTR + kk * 16 + 8 * h);
    bf16x8 v1 = ldsv(Vs + (32 + r) * LSTR + kk * 16 + 8 * h);
    o0 = mfma(v0, pf, o0);
    o1 = mfma(v1, pf, o1);
  }
}

DI void load_gate_rows(u32x2 (&gv)[8], const u16* grow0, int lane) {
#pragma unroll
  for (int t = 0; t < 8; ++t) gv[t] = __builtin_nontemporal_load((const u32x2*)(grow0 + (size_t)((lane >> 4) + 4 * t) * DIN + (lane & 15) * 4));
}
DI void store_y(const f32x16& oa, const f32x16& ob, float mult, const float* sg, const u32x2 (&gv)[8], u16* yrow0, float* stg,
                int lane, int r, int h) {
#pragma unroll
  for (int dt = 0; dt < 2; ++dt)
#pragma unroll
    for (int g = 0; g < 4; ++g) {
      f32x4 v;
      v[0] = (dt ? ob[4 * g] : oa[4 * g]) * mult; v[1] = (dt ? ob[4 * g + 1] : oa[4 * g + 1]) * mult;
      v[2] = (dt ? ob[4 * g + 2] : oa[4 * g + 2]) * mult; v[3] = (dt ? ob[4 * g + 3] : oa[4 * g + 3]) * mult;
      *(f32x4*)(stg + r * 68 + 32 * dt + 8 * g + 4 * h) = v;
    }
  const int kc = lane & 15;
  f32x4 sv = {1.f, 1.f, 1.f, 1.f};
  if (sg) sv = *(const f32x4*)(sg + kc * 4);
#pragma unroll
  for (int t = 0; t < 8; ++t) {
    const int row = (lane >> 4) + 4 * t;
    const f32x4 v = *(const f32x4*)(stg + row * 68 + kc * 4);
    float y0 = v[0] * sv[0] * silu(bflo(gv[t][0]));
    float y1 = v[1] * sv[1] * silu(bfhi(gv[t][0]));
    float y2 = v[2] * sv[2] * silu(bflo(gv[t][1]));
    float y3 = v[3] * sv[3] * silu(bfhi(gv[t][1]));
    u32x2 yo = {pk2(y0, y1), pk2(y2, y3)};
    *(u32x2*)(yrow0 + (size_t)row * DM + kc * 4) = yo;
  }
}

DI void attn_item_A(const Params& p, int layer, int b, int head, int qb, u16* sm, float lam, float lam_init, int wv) {
  const int tid = tid_now(wv), lane = tid & 63, w = tid >> 6, r = lane & 31, h = lane >> 5;
  const int qsub = w & 1, kh = w >> 1;
  const int q0 = qb * 64, q0w = q0 + 32 * qsub, qpos = q0w + r;
  const int qoff = head * 64, koff = 256 + head * 64, vh = head, goff = 768 + head * 64, yoff = head * 64;
  const u16* projb = p.proj + (size_t)b * SEQ * DIN;
  u16* Kb0 = sm + kh * (4 * 64 * 64);

  bf16x8 qf[4];
#pragma unroll
  for (int ks = 0; ks < 4; ++ks) qf[ks] = __builtin_nontemporal_load((const bf16x8*)(projb + (size_t)qpos * DIN + qoff + 16 * ks + 8 * h));
  const float sl2 = exp2f(-8.f * (float)(9 + head) / 12.f) * LOG2E;
  int lo[4];
#pragma unroll
  for (int c = 0; c < 4; ++c) lo[c] = r * 64 + (((2 * c + h) ^ ((r >> 1) & 7)) * 8);

  const int t7 = tid & 127, wp = t7 >> 6;
  const int csrc = (lane & 7) ^ ((4 * wp + (lane >> 4)) & 7);
  const int row0 = wp * 8 + (lane >> 3);
  const u16* kg = projb + koff + csrc * 8;
  const u16* vg = p.vt + ((size_t)(b * NVH + vh) * 64) * SEQ + csrc * 8;

  float zf = 0.f;
  asm volatile("" : "+v"(zf));
  f32x16 o[2][2];
#pragma unroll
  for (int a = 0; a < 2; ++a)
#pragma unroll
    for (int d = 0; d < 2; ++d)
#pragma unroll
      for (int e = 0; e < 16; ++e) o[a][d][e] = zf;
  float m0 = 0.f, m1 = 0.f;
  f32x4 ls0 = {zf, zf, zf, zf}, ls1 = {zf, zf, zf, zf};
  const bf16x8 ones = rowsum_ones(lane);
  bool started = false;

  const int npairs = (qb >> 1) + 1;
  const int T0 = 2 * (npairs - 1) + kh;
  const bool v0 = (T0 <= qb);
  auto dma_tile = [&](int T, int c) {
    const int k0 = 64 * T;
    u16* Kd = Kb0 + c * (2 * 64 * 64) + wp * (8 * 64);
#pragma unroll
    for (int i = 0; i < 4; ++i) {
      __builtin_amdgcn_global_load_lds((const unsigned*)(kg + (size_t)(k0 + row0 + 16 * i) * DIN), (unsigned*)(Kd + i * 16 * 64), 16, 0, 0);
      __builtin_amdgcn_global_load_lds((const unsigned*)(vg + (size_t)(row0 + 16 * i) * SEQ + k0), (unsigned*)(Kd + 64 * 64 + i * 16 * 64), 16, 0, 0);
    }
  };
  if (v0) dma_tile(T0, 0);
  asm volatile("" :: "v"(qf[0]), "v"(qf[1]), "v"(qf[2]), "v"(qf[3]));
  asm volatile("s_waitcnt vmcnt(0)" ::: "memory");
  __syncthreads();
  for (int j = 0; j < npairs; ++j) {
    if (j + 1 < npairs) dma_tile(T0 - 2 * (j + 1), (j + 1) & 1);
    if (j > 0 || v0) {
      const int T = T0 - 2 * j;
      const u16* Ks = Kb0 + (j & 1) * (2 * 64 * 64);
      const u16* Vs = Ks + 64 * 64;
      const int k0 = 64 * T;
      const bool need_mask = (T == qb);
      const int dl = qpos - k0 - 4 * h;
      diff_softmax_pv(qf, Ks, Vs, m0, ls0, ls1, ones, o, sl2, dl, need_mask, !started, r, h, 64, lo);
      m1 = m0;
      started = true;
    }
    asm volatile("s_waitcnt vmcnt(0)" ::: "memory");
    __syncthreads();
  }

  if (!started) { m0 = -INFINITY; m1 = -INFINITY; }
  float l0 = own_rowsum(ls0, r), l1 = own_rowsum(ls1, r);
  u32x2 gate[8];
  if (kh == 0) load_gate_rows(gate, projb + (size_t)q0w * DIN + goff, lane);
  float* cb = (float*)sm + (size_t)qsub * 68 * 64 + lane;
  if (kh == 1) {
#pragma unroll
    for (int a = 0; a < 2; ++a)
#pragma unroll
      for (int d = 0; d < 2; ++d)
#pragma unroll
        for (int e = 0; e < 16; ++e) cb[((a * 2 + d) * 16 + e) * 64] = o[a][d][e];
    cb[64 * 64] = m0; cb[65 * 64] = l0; cb[66 * 64] = m1; cb[67 * 64] = l1;
  }
  __syncthreads();
  if (kh == 0) {
    {
      const float mb = cb[64 * 64], lb = cb[65 * 64];
      const float mn = fmaxf(m0, mb), fa = ex2(m0 - mn), fb = ex2(mb - mn);
      l0 = l0 * fa + lb * fb;
#pragma unroll
      for (int d = 0; d < 2; ++d)
#pragma unroll
        for (int e = 0; e < 16; ++e) o[0][d][e] = o[0][d][e] * fa + cb[((0 * 2 + d) * 16 + e) * 64] * fb;
    }
    {
      const float mb = cb[66 * 64], lb = cb[67 * 64];
      const float mn = fmaxf(m1, mb), fa = ex2(m1 - mn), fb = ex2(mb - mn);
      l1 = l1 * fa + lb * fb;
#pragma unroll
      for (int d = 0; d < 2; ++d)
#pragma unroll
        for (int e = 0; e < 16; ++e) o[1][d][e] = o[1][d][e] * fa + cb[((1 * 2 + d) * 16 + e) * 64] * fb;
    }
    const float inv0 = 1.f / l0, inv1 = lam / l1;
    float sq = 0.f;
#pragma unroll
    for (int dt = 0; dt < 2; ++dt)
#pragma unroll
      for (int e = 0; e < 16; ++e) {
        float v = o[0][dt][e] * inv0 - o[1][dt][e] * inv1;
        o[0][dt][e] = v;
        sq += v * v;
      }
    sq += shx(sq, lane);
    const float mult = __builtin_amdgcn_rsqf(sq * (1.f / 64.f) + EPS) * (1.f - lam_init);
    store_y(o[0][0], o[0][1], mult, p.subln_g + layer * 64, gate,
            p.y + ((size_t)b * SEQ + q0w) * DM + yoff, (float*)sm + 9216 + w * 2176, lane, r, h);
  }
}

template <int MODE>
DI void attn_item(const Params& p, int layer, int b, int head, int qblk, u16* sm, volatile LAS int* s_done_, int wv) {
  const int tid = tid_now(wv), lane = tid & 63, w = tid >> 6, r = lane & 31, h = lane >> 5;
  const int q0 = qblk * 128, q0w = q0 + 32 * w, qpos = q0w + r;
  int qoff, koff, vh, goff, yoff;
  if (MODE == 1) { qoff = 1024 + head * 64; koff = 1536 + (head >> 2) * 64; vh = 4 + (head >> 2); goff = 1792 + head * 64; yoff = 256 + head * 64; }
  else { qoff = 2304 + head * 64; koff = 2560 + head * 64; vh = 6 + head; goff = 3072 + head * 64; yoff = 768 + head * 64; }
  const u16* projb = p.proj + (size_t)b * SEQ * DIN;
  u16* Ks = sm;
  u16* Vs = sm + 64 * LSTR;

  bf16x8 qf[4];
#pragma unroll
  for (int ks = 0; ks < 4; ++ks) qf[ks] = __builtin_nontemporal_load((const bf16x8*)(projb + (size_t)qpos * DIN + qoff + 16 * ks + 8 * h));

  float sl2 = 0.f;
  if (MODE == 1) sl2 = exp2f(-8.f * (float)(1 + head) / 12.f) * LOG2E;
  int lo[4];
#pragma unroll
  for (int c = 0; c < 4; ++c) lo[c] = r * LSTR + c * 16 + 8 * h;

  int it0 = 0, ntiles;
  if (MODE == 1) { ntiles = 4; it0 = (qblk == 0) ? 2 : 0; }
  else ntiles = 2 * (qblk + 1);

  const u16* kg = projb + koff + (tid & 7) * 8;
  const u16* vg = p.vt + ((size_t)(b * NVH + vh) * 64) * SEQ + (tid & 7) * 8;
  const int row0 = tid >> 3;
  const int loff = row0 * LSTR + (tid & 7) * 8;

  f32x16 o[2];
#pragma unroll
  for (int d = 0; d < 2; ++d)
#pragma unroll
    for (int e = 0; e < 16; ++e) o[d][e] = 0.f;
  float m0 = -INFINITY, R = 0.f;
  f32x16 ls0;
#pragma unroll
  for (int e = 0; e < 16; ++e) ls0[e] = (MODE == 1) ? 1.f : 0.f;
  if (MODE == 1) m0 = p.sinks[layer * 8 + head] * LOG2E;
  int wdone = 0;
  volatile LAS int* s_done = lds_fresh(s_done_);
  if (MODE == 2 && lane == 0) s_done[w] = 0;

  auto tile_k0 = [&](int it) -> int {
    if (MODE == 1) return q0 - 128 + 64 * it;
    return 64 * (ntiles - 1 - it);
  };
  u32x2 gate[8];
  load_gate_rows(gate, projb + (size_t)q0w * DIN + goff, lane);
  bool stop = false;
  for (int base = 0; base < ntiles && !stop; base += 4) {
    u32x4 rk[4][2], rv[4][2];
#pragma unroll
    for (int c = 0; c < 4; ++c) {
      const int it = base + c;
      if (it >= it0 && it < ntiles) {
        const int k0 = tile_k0(it);
#pragma unroll
        for (int i = 0; i < 2; ++i) {
          rk[c][i] = *(const u32x4*)(kg + (size_t)(k0 + row0 + 32 * i) * DIN);
          rv[c][i] = *(const u32x4*)(vg + (size_t)(row0 + 32 * i) * SEQ + k0);
        }
      }
    }
    __syncthreads();
    if (MODE == 2 && base > 0 && (s_done[0] & s_done[1] & s_done[2] & s_done[3])) { stop = true; }
    if (!stop) {
#pragma unroll
      for (int c = 0; c < 4; ++c) {
        const int it = base + c;
        if (it >= it0 && it < ntiles) {
#pragma unroll
          for (int i = 0; i < 2; ++i) {
            *(u32x4*)(Ks + c * (2 * 64 * LSTR) + loff + i * 32 * LSTR) = rk[c][i];
            *(u32x4*)(Vs + c * (2 * 64 * LSTR) + loff + i * 32 * LSTR) = rv[c][i];
          }
        }
      }
    }
    __syncthreads();
    if (!stop) {
#pragma unroll
      for (int c = 0; c < 4; ++c) {
        const int it = base + c;
        if (it >= it0 && it < ntiles) {
          const u16* Kc = Ks + c * (2 * 64 * LSTR);
          const u16* Vc = Vs + c * (2 * 64 * LSTR);
          const int k0 = tile_k0(it);
          bool skip, need_mask;
          if (MODE == 1) { skip = (k0 > q0w + 31) || (k0 + 63 < q0w - 127); need_mask = true; }
          else { skip = (k0 >= q0w + 31) || wdone; need_mask = (k0 + 63 >= q0w); }
          if (!skip) {
            const int dl = qpos - k0 - 4 * h;
            if (MODE == 1) {
              softmax_pv<1, 0, 4>(qf, Kc, Vc, m0, ls0, o[0], o[1], sl2, dl, need_mask, false, r, h, LSTR, lo);
            } else {
              f32x16 sa[2];
#pragma unroll
              for (int e = 0; e < 16; ++e) { sa[0][e] = 0.f; sa[1][e] = 0.f; }
#pragma unroll
              for (int t = 0; t < 2; ++t)
#pragma unroll
                for (int ks = 0; ks < 4; ++ks) {
                  bf16x8 kf = ldsv(Kc + (32 * t + r) * LSTR + ks * 16 + 8 * h);
                  sa[t] = mfma(kf, qf[ks], sa[t]);
                }
              stick_pv(sa[0], sa[1], R, o[0], o[1], Vc, dl, need_mask, r, h);
              wdone = __all(R < -160.f) ? 1 : 0;
            }
          }
        }
      }
      if (MODE == 2 && lane == 0) s_done[w] = wdone;
    }
  }
  __syncthreads();

  float inv = 1.f;
  if (MODE == 1) inv = 1.f / ls0[0];
  store_y(o[0], o[1], inv, nullptr, gate, p.y + ((size_t)b * SEQ + q0w) * DM + yoff,
          (float*)sm + 9216 + w * 2176, lane, r, h);
}

DI void attn_item_B2(const Params& p, int layer, int b, int head0, int qblk, u16* sm, int wv) {
  asm volatile("" : "+s"(head0));
  const int tid = tid_now(wv), lane = tid & 63, w = tid >> 6, r = lane & 31, h = lane >> 5;
  const int q0 = qblk * 128, q0w = q0 + 32 * w, qpos = q0w + r;
  const int koff = 1536 + (head0 >> 2) * 64, vh = 4 + (head0 >> 2);
  const u16* projb = p.proj + (size_t)b * SEQ * DIN;
  u16* Ks = sm;
  u16* Vs = sm + 64 * LSTR;
  const int it0 = (qblk == 0) ? 2 : 0;

  bf16x8 qf[2][4];
  u32x2 gate[2][8];
#pragma unroll
  for (int hh = 0; hh < 2; ++hh) {
#pragma unroll
    for (int ks = 0; ks < 4; ++ks)
      qf[hh][ks] = __builtin_nontemporal_load((const bf16x8*)(projb + (size_t)qpos * DIN + 1024 + (head0 + hh) * 64 + 16 * ks + 8 * h));
    load_gate_rows(gate[hh], projb + (size_t)q0w * DIN + 1792 + (head0 + hh) * 64, lane);
  }
  int lo[4];
#pragma unroll
  for (int c = 0; c < 4; ++c) lo[c] = r * LSTR + c * 16 + 8 * h;

  const u16* kg = projb + koff + (tid & 7) * 8;
  const u16* vg = p.vt + ((size_t)(b * NVH + vh) * 64) * SEQ + (tid & 7) * 8;
  const int row0 = tid >> 3;
  const int loff = row0 * LSTR + (tid & 7) * 8;
  {
    u32x4 rk[4][2], rv[4][2];
#pragma unroll
    for (int c = 0; c < 4; ++c) {
      if (c >= it0) {
        const int k0 = q0 - 128 + 64 * c;
#pragma unroll
        for (int i = 0; i < 2; ++i) {
          rk[c][i] = *(const u32x4*)(kg + (size_t)(k0 + row0 + 32 * i) * DIN);
          rv[c][i] = *(const u32x4*)(vg + (size_t)(row0 + 32 * i) * SEQ + k0);
        }
      }
    }
    __syncthreads();
#pragma unroll
    for (int c = 0; c < 4; ++c) {
      if (c >= it0) {
#pragma unroll
        for (int i = 0; i < 2; ++i) {
          *(u32x4*)(Ks + c * (2 * 64 * LSTR) + loff + i * 32 * LSTR) = rk[c][i];
          *(u32x4*)(Vs + c * (2 * 64 * LSTR) + loff + i * 32 * LSTR) = rv[c][i];
        }
      }
    }
    __syncthreads();
  }
  float zf = 0.f, onef = 1.f;
  asm volatile("" : "+v"(zf), "+v"(onef));
  f32x16 o[2][2], ls[2];
  float mref[2];
#pragma unroll
  for (int hh = 0; hh < 2; ++hh) {
    const int head = head0 + hh;
    const float sl2 = exp2f(-8.f * (float)(1 + head) / 12.f) * LOG2E;
#pragma unroll
    for (int e = 0; e < 16; ++e) { o[hh][0][e] = zf; o[hh][1][e] = zf; ls[hh][e] = onef; }
    mref[hh] = p.sinks[layer * 8 + head] * LOG2E;
#pragma unroll
    for (int c = 0; c < 4; ++c) {
      if (c >= it0) {
        const int k0 = q0 - 128 + 64 * c;
        const bool skip = (k0 > q0w + 31) || (k0 + 63 < q0w - 127);
        if (!skip) {
          const int dl = qpos - k0 - 4 * h;
          softmax_pv<1, 0, 4>(qf[hh], Ks + c * (2 * 64 * LSTR), Vs + c * (2 * 64 * LSTR), mref[hh], ls[hh], o[hh][0], o[hh][1],
                              sl2, dl, true, false, r, h, LSTR, lo);
        }
      }
    }
  }
  __syncthreads();
#pragma unroll
  for (int hh = 0; hh < 2; ++hh)
    store_y(o[hh][0], o[hh][1], 1.f / ls[hh][0], nullptr, gate[hh], p.y + ((size_t)b * SEQ + q0w) * DM + 256 + (head0 + hh) * 64,
            (float*)sm + 9216 + w * 2176, lane, r, h);
}

__global__ void __launch_bounds__(256, 2) hymba_mega(Params p) {
  cg::grid_group grid = cg::this_grid();
  __shared__ __attribute__((aligned(16))) u16 sm[SMEM_U16];
  __shared__ int s_item;
  __shared__ int s_done[4];
  const int wv = __builtin_amdgcn_readfirstlane((int)threadIdx.x >> 6);
  const int bid = blockIdx.x, nb = gridDim.x;
  const int xcd = bid & 7, lb = bid >> 3, nxb = nb >> 3;
  __shared__ __attribute__((aligned(16))) unsigned xb_words[4];
  if (tid_now(wv) == 0) { xb_words[0] = 0u; xb_words[1] = 0u; xb_words[2] = 0u; xb_words[3] = 0u; }
  __syncthreads();
  const XcdBarrier gb = xcd_barrier_post(p.bar, (volatile LAS unsigned*)xb_words, wv);
  if (p.never) grid.sync();

  for (int rep = 0; rep < REP_PREP; ++rep) { phase_prep(p, sm, wv); xcd_barrier(gb); }

  for (int layer = 0; layer < DEPTH; ++layer) {
    for (int rep = 0; rep < REP_G0; ++rep) {
      for (int u = lb; u < 8 * 26; u += nxb) gemm_tile<0>(p, layer, xcd + 8 * (u & 7), u >> 3, sm, wv);
      xcd_barrier(gb);
    }

    {
      const float lam_init = 0.8f - 0.6f * expf(-0.3f * (float)layer);
      float d1 = 0.f, d2 = 0.f;
      for (int i = 0; i < 32; ++i) {
        d1 += p.lq1[layer * 32 + i] * p.lk1[layer * 32 + i];
        d2 += p.lq2[layer * 32 + i] * p.lk2[layer * 32 + i];
      }
      const float lam = expf(d1) - expf(d2) + lam_init;
      for (int rep = 0; rep < REP_ATT; ++rep) {
      if (rep) xcd_barrier(gb);
      unsigned* qctr = p.ctr + (rep * 2 + layer) * 8 + xcd;
      for (;;) {
        __syncthreads();
        volatile LAS int* sit = lds_fresh((volatile LAS int*)&s_item);
        if (tid_now(wv) == 0) *sit = (int)atomicAdd(qctr, 1u);
        __syncthreads();
        const int item = *sit;
        if (item >= N_ITEMS_XCD) break;
        const int slot = (item < 128) ? 0 : (item < 192) ? 1 : 3, per = (item < 128) ? 0 : (item < 192) ? item - 128 : item - 192;
        if (slot == 0 || slot == 2) {
          const int ia = item;
          if (!(rep && (0 < REP_LO || 128 > REP_HI)))
          attn_item_A(p, layer, xcd >> 2, xcd & 3, 127 - ia, sm, lam, lam_init, wv);
        } else if (slot == 1) {
          if (!(rep && (128 < REP_LO || 192 > REP_HI)))
          attn_item_B2(p, layer, (2 * xcd) >> 3, (2 * xcd) & 7, 63 - per, sm, wv);
        } else {
          if (!(rep && (192 < REP_LO || 256 > REP_HI)))
          attn_item<2>(p, layer, xcd >> 2, xcd & 3, 63 - per, sm, (volatile LAS int*)s_done, wv);
        }
      }
      }
    }
    xcd_barrier(gb);

    for (int u = lb; u < 8 * 8; u += nxb) gemm_tile<1>(p, layer, xcd + 8 * (u & 7), u >> 3, sm, wv);
    xcd_barrier(gb);
  }

  {
    const int tid = tid_now(wv), lane = tid & 63;
    const float* ssf = p.ss + (size_t)DEPTH * MTOK;
    f32x4 gv[4];
#pragma unroll
    for (int j = 0; j < 4; ++j) gv[j] = *(const f32x4*)(p.final_g + j * 256 + lane * 4);
    for (int row0 = (bid * 4 + (tid >> 6)) * 4; row0 < MTOK; row0 += nb * 16) {
      f32x4 xv[4][4];
      float rs[4];
#pragma unroll
      for (int q = 0; q < 4; ++q) {
        rs[q] = ssf[row0 + q];
#pragma unroll
        for (int j = 0; j < 4; ++j) {
          const u32x2 xb = __builtin_nontemporal_load((const u32x2*)((const u16*)p.x2 + (size_t)(row0 + q) * DM + j * 256 + lane * 4));
          xv[q][j][0] = bflo(xb[0]); xv[q][j][1] = bfhi(xb[0]); xv[q][j][2] = bflo(xb[1]); xv[q][j][3] = bfhi(xb[1]);
        }
      }
#pragma unroll
      for (int q = 0; q < 4; ++q) {
        const float rq = __builtin_amdgcn_rsqf(rs[q] * (1.f / DM) + EPS);
#pragma unroll
        for (int j = 0; j < 4; ++j) {
          f32x4 v = xv[q][j];
          v[0] *= rq * gv[j][0]; v[1] *= rq * gv[j][1]; v[2] *= rq * gv[j][2]; v[3] *= rq * gv[j][3];
          __builtin_nontemporal_store(v, (f32x4*)(p.out + (size_t)(row0 + q) * DM + j * 256 + lane * 4));
        }
      }
    }
  }
}

extern "C" void kernel_launch(void* const* d_in, const int* in_sizes, int n_in, void* d_out, int out_size, void* d_ws,
                              size_t ws_size, hipStream_t stream) {
  static int grid_blocks = 0;
  if (!grid_blocks) {
    int dev = 0, cus = 0, per_cu = 0;
    hipGetDevice(&dev);
    hipDeviceGetAttribute(&cus, hipDeviceAttributeMultiprocessorCount, dev);
    hipOccupancyMaxActiveBlocksPerMultiprocessor(&per_cu, hymba_mega, 256, 0);
    if (per_cu > 2) per_cu = 2;
    if (per_cu < 1) per_cu = 1;
    grid_blocks = cus * per_cu;
    grid_blocks -= grid_blocks % 8;
  }
  Params p{};
  p.x = (const float*)d_in[0]; p.norm_g = (const float*)d_in[1]; p.w_in = (const float*)d_in[2];
  p.lq1 = (const float*)d_in[3]; p.lk1 = (const float*)d_in[4]; p.lq2 = (const float*)d_in[5];
  p.lk2 = (const float*)d_in[6]; p.subln_g = (const float*)d_in[7]; p.sinks = (const float*)d_in[8];
  p.w_out = (const float*)d_in[9]; p.final_g = (const float*)d_in[10];
  p.out = (float*)d_out;
  char* ws = (char*)d_ws;
  size_t off = 0;
  auto take = [&](size_t bytes) { char* q = ws + off; off += (bytes + 255) & ~(size_t)255; return q; };
  p.wtin = (u16*)take((size_t)DEPTH * DIN * 1024 * 2);
  p.wtout = (u16*)take((size_t)DEPTH * 1024 * 1024 * 2);
  p.xg = (u16*)take((size_t)MTOK * DM * 2);
  p.proj = (u16*)take((size_t)MTOK * DIN * 2);
  p.vt = (u16*)take((size_t)NBATCH * NVH * 64 * SEQ * 2);
  p.y = (u16*)take((size_t)MTOK * DM * 2);
  p.ss = (float*)take((size_t)3 * MTOK * 4);
  p.ctr = (unsigned*)take(256);
  p.bar = (unsigned*)take((size_t)XCD_BAR_WORDS * 4);
  p.x2 = (float*)p.proj;
  p.never = 0;
  (void)hipMemsetAsync(p.bar, 0, (size_t)XCD_BAR_WORDS * 4, stream);
  void* args[] = {&p};
  hipError_t e = hipLaunchCooperativeKernel((void*)hymba_mega, dim3(grid_blocks), dim3(256), args, 0, stream);
  if (e != hipSuccess) fprintf(stderr, "cooperative launch failed: %s (grid %d)\n", hipGetErrorString(e), grid_blocks);
}
```

```cpp
#include <hip/hip_runtime.h>
#include <hip/hip_cooperative_groups.h>
#include <cstdio>
namespace cg = cooperative_groups;

#define DI __device__ __forceinline__
#define LAS __attribute__((address_space(3)))
typedef unsigned short u16;
typedef __attribute__((ext_vector_type(8))) __bf16 bf16x8;
typedef __attribute__((ext_vector_type(2))) __bf16 bf16x2;
typedef __attribute__((ext_vector_type(16))) float f32x16;
typedef __attribute__((ext_vector_type(2))) float f32x2;
typedef __attribute__((ext_vector_type(4))) unsigned u32x4;
typedef __attribute__((ext_vector_type(2))) unsigned u32x2;
typedef __attribute__((ext_vector_type(4))) float f32x4;

constexpr int SEQ = 8192, NBATCH = 2, DM = 1024, MTOK = NBATCH * SEQ, DIN = 3328, DEPTH = 2, NVH = 10;
constexpr float EPS = 1e-5f, LOG2E = 1.4426950408889634f;
constexpr int LSTR = 72;
constexpr int SMEM_U16 = 8 * 64 * LSTR;
constexpr int N_ITEMS_XCD = 128 + 64 + 64;
#ifndef REP_PREP
#define REP_PREP 1
#endif
#ifndef REP_G0
#define REP_G0 1
#endif
#ifndef REP_ATT
#define REP_ATT 1
#endif
#ifndef REP_LO
#define REP_LO 0
#endif
#ifndef REP_HI
#define REP_HI N_ITEMS_XCD
#endif

struct Params {
  const float *x, *norm_g, *w_in, *lq1, *lk1, *lq2, *lk2, *subln_g, *sinks, *w_out, *final_g;
  float* out;
  u16* wtin;
  u16* wtout;
  u16* xg;
  u16* proj;
  u16* vt;
  u16* y;
  float* ss;
  unsigned* ctr;
  unsigned* bar;
  float* x2;
  size_t never;
};

DI unsigned pk2(float a, float b) {
  f32x2 v = {a, b};
  bf16x2 r = __builtin_convertvector(v, bf16x2);
  return __builtin_bit_cast(unsigned, r);
}
DI uint2 pk4(float a, float b, float c, float d) { uint2 r; r.x = pk2(a, b); r.y = pk2(c, d); return r; }
DI float bflo(unsigned v) { return __uint_as_float(v << 16); }
DI float bfhi(unsigned v) { return __uint_as_float(v & 0xffff0000u); }
DI float ex2(float x) { return __builtin_amdgcn_exp2f(x); }

DI float lg2(float x) { return __builtin_amdgcn_logf(x); }
DI f32x16 mfma(bf16x8 a, bf16x8 b, f32x16 c) { return __builtin_amdgcn_mfma_f32_32x32x16_bf16(a, b, c, 0, 0, 0); }
DI bf16x8 ldsv(const u16* p) { return *(const bf16x8*)p; }
DI float silu(float g) { return g * __builtin_amdgcn_rcpf(1.f + ex2(-g * LOG2E)); }
DI int tid_now(int wv) {
  int t;
  asm volatile("v_mbcnt_lo_u32_b32 %0, -1, 0\n\tv_mbcnt_hi_u32_b32 %0, -1, %0" : "=v"(t));
  return wv * 64 + t;
}
DI float shx(float v, int lane, int o = 32) {
  return __int_as_float(__builtin_amdgcn_ds_bpermute((lane ^ o) << 2, __float_as_int(v)));
}
template <typename T> DI volatile LAS T* lds_fresh(volatile LAS T* q) { asm volatile("" : "+v"(q)); return q; }
DI float wave_sum(float v, int lane) {
#pragma unroll
  for (int o = 32; o >= 1; o >>= 1) v += shx(v, lane, o);
  return v;
}


#define XB_TMO      128
#define XB_XCNT(j)  (256  + 64 * (j))
#define XB_XSUB(j)  (1280 + 64 * (j))
#define XB_XGEN(j)  (2304 + 64 * (j))
#define XB_TOP      3328
#define XB_TOPGEN   3392
#define XCD_BAR_WORDS 3456
#define XB_SPIN_CAP (1u << 18)
DI unsigned xb_ld(unsigned* p) { return __hip_atomic_load(p, __ATOMIC_RELAXED, __HIP_MEMORY_SCOPE_AGENT); }
DI unsigned xb_add(unsigned* p, unsigned v) { return __hip_atomic_fetch_add(p, v, __ATOMIC_RELAXED, __HIP_MEMORY_SCOPE_AGENT); }
DI unsigned xb_xcc_id() { return (unsigned)__builtin_amdgcn_s_getreg((3 << 11) | 20) & 0xFu; }
#define XB_SPIN(cond, bar) do { unsigned _sp = 0; while (cond) { __builtin_amdgcn_s_sleep(1); \
    if ((++_sp & 255u) == 0u) { if (xb_ld(&(bar)[XB_TMO])) break; if (_sp > XB_SPIN_CAP) { atomicAdd(&(bar)[XB_TMO], 1u); break; } } } } while (0)
struct XcdBarrier { unsigned* bar; unsigned x; volatile LAS unsigned* st; int wv; };
DI XcdBarrier xcd_barrier_post(unsigned* bar, volatile LAS unsigned* st, int wv) {
  XcdBarrier b; b.bar = bar; b.x = xb_xcc_id(); b.st = st; b.wv = wv;
  if (tid_now(wv) == 0) (void)xb_add(&bar[XB_XCNT(b.x)], 1u);
  return b;
}
DI void xcd_barrier_complete(unsigned* bar, unsigned x, unsigned& nloc, unsigned& nx) {
  const unsigned G = gridDim.x * gridDim.y * gridDim.z;
  unsigned sum, cnt, mine, sp = 0u;
  for (;;) {
    sum = 0u; cnt = 0u; mine = 0u;
#pragma unroll
    for (unsigned j = 0; j < 16; ++j) { const unsigned c = xb_ld(&bar[XB_XCNT(j)]); sum += c; cnt += (c > 0u) ? 1u : 0u; mine = (j == x) ? c : mine; }
    if (sum == G) break;
    __builtin_amdgcn_s_sleep(1);
    if ((++sp & 255u) == 0u) { if (xb_ld(&bar[XB_TMO])) break; if (sp > XB_SPIN_CAP) { atomicAdd(&bar[XB_TMO], 1u); break; } }
  }
  nloc = mine > 0u ? mine : 1u; nx = cnt > 0u ? cnt : 1u;
}
DI void xcd_barrier(const XcdBarrier& b) {
  asm volatile("s_waitcnt vmcnt(0)" ::: "memory");
  __syncthreads();
  if (tid_now(b.wv) == 0) {
    unsigned* bar = b.bar;
    __builtin_amdgcn_s_waitcnt(0);
    volatile LAS unsigned* st = lds_fresh(b.st);
    unsigned nloc = st[0], nx = st[1];
    if (nloc == 0u) { xcd_barrier_complete(bar, b.x, nloc, nx); st[0] = nloc; st[1] = nx; }
    const unsigned old = xb_add(&bar[XB_XSUB(b.x)], 1u);
    const unsigned gen = old / nloc;
    if (old + 1u == (gen + 1u) * nloc) {
      __builtin_amdgcn_fence(__ATOMIC_RELEASE, "agent");
      asm volatile("s_waitcnt vmcnt(0)" ::: "memory");
      const unsigned og = xb_add(&bar[XB_TOP], 1u);
      const unsigned tg = og / nx;
      if (og + 1u == (tg + 1u) * nx) xb_add(&bar[XB_TOPGEN], 1u);
      else XB_SPIN(xb_ld(&bar[XB_TOPGEN]) == tg, bar);
      __builtin_amdgcn_fence(__ATOMIC_ACQUIRE, "agent");
      xb_add(&bar[XB_XGEN(b.x)], 1u);
      asm volatile("s_waitcnt vmcnt(0)" ::: "memory");
    } else {
      XB_SPIN(xb_ld(&bar[XB_XGEN(b.x)]) == gen, bar);
      __builtin_amdgcn_fence(__ATOMIC_ACQUIRE, "agent");
      asm volatile("s_waitcnt vmcnt(0)" ::: "memory");
    }
  }
  __syncthreads();
}

DI void phase_prep(const Params& p, u16* sm, int wv) {
  const int tid = tid_now(wv), nb = gridDim.x, bid = blockIdx.x;
  float* smf = (float*)sm;
  constexpr int T_IN = DEPTH * 16 * 52, T_OUT = DEPTH * 16 * 16;
  for (int t = bid; t < T_IN + T_OUT; t += nb) {
    const float* src; u16* dst; int N, kt, nt; const float* gsc = nullptr;
    if (t < T_IN) {
      int l = t / 832, rr = t % 832; kt = rr / 52; nt = rr % 52; N = DIN;
      src = p.w_in + (size_t)l * 1024 * DIN; dst = p.wtin + (size_t)l * DIN * 1024; gsc = p.norm_g + l * DM;
    } else {
      int u = t - T_IN; int l = u / 256, rr = u % 256; kt = rr / 16; nt = rr % 16; N = 1024;
      src = p.w_out + (size_t)l * 1024 * 1024; dst = p.wtout + (size_t)l * 1024 * 1024;
    }
    __syncthreads();
#pragma unroll
    for (int i = 0; i < 4; ++i) {
      const int k = i * 16 + (tid >> 4), n4 = (tid & 15) * 4;
      const f32x4 v = __builtin_nontemporal_load((const f32x4*)(src + (size_t)(kt * 64 + k) * N + nt * 64 + n4));
      const float gk = gsc ? gsc[kt * 64 + k] : 1.f;
      smf[(n4 + 0) * 65 + k] = v[0] * gk; smf[(n4 + 1) * 65 + k] = v[1] * gk;
      smf[(n4 + 2) * 65 + k] = v[2] * gk; smf[(n4 + 3) * 65 + k] = v[3] * gk;
    }
    __syncthreads();
#pragma unroll
    for (int j = 0; j < 2; ++j) {
      const int c = tid + 256 * j, kc = c & 7, n = c >> 3;
      const float* q = smf + n * 65 + kc * 8;
      u32x4 o = {pk2(q[0], q[1]), pk2(q[2], q[3]), pk2(q[4], q[5]), pk2(q[6], q[7])};
      *(u32x4*)(dst + (size_t)(nt * 64 + n) * 1024 + kt * 64 + kc * 8) = o;
    }
  }
  const int lane = tid & 63;
  {
    for (int row0 = (bid * 4 + (tid >> 6)) * 4; row0 < MTOK; row0 += nb * 16) {
      f32x4 xv[4][4];
#pragma unroll
      for (int q = 0; q < 4; ++q)
#pragma unroll
        for (int j = 0; j < 4; ++j) xv[q][j] = __builtin_nontemporal_load((const f32x4*)(p.x + (size_t)(row0 + q) * DM + j * 256 + lane * 4));
#pragma unroll
      for (int q = 0; q < 4; ++q) {
        float sq = 0.f;
#pragma unroll
        for (int j = 0; j < 4; ++j) {
          const f32x4 v = xv[q][j];
          sq += v[0] * v[0] + v[1] * v[1] + v[2] * v[2] + v[3] * v[3];
          u32x2 o = {pk2(v[0], v[1]), pk2(v[2], v[3])};
          *(u32x2*)(p.xg + (size_t)(row0 + q) * DM + j * 256 + lane * 4) = o;
        }
        sq = wave_sum(sq, lane);
        if (lane == 0) p.ss[row0 + q] = sq;
      }
    }
  }
  for (int i = bid * 256 + tid; i < 2 * MTOK; i += nb * 256) p.ss[MTOK + i] = 0.f;
  if (bid == 0 && tid < 64) p.ctr[tid] = 0u;
}

constexpr int GSTR = 80;
DI f32x4 mfma16(bf16x8 a, bf16x8 b, f32x4 c) { return __builtin_amdgcn_mfma_f32_16x16x32_bf16(a, b, c, 0, 0, 0); }

template <bool VT>
DI void gemm_kslab(f32x4 (&acc)[8][4], const u16* sA, const u16* sB, int wm, int wn, int fr, int fq) {
#pragma unroll
  for (int ks = 0; ks < 2; ++ks) {
    bf16x8 tb[4], ta[8];
#pragma unroll
    for (int j = 0; j < 4; ++j) tb[j] = ldsv(sB + (wn * 64 + 16 * j + fr) * GSTR + ks * 32 + 8 * fq);
#pragma unroll
    for (int i = 0; i < 8; ++i) ta[i] = ldsv(sA + (wm * 128 + 16 * i + fr) * GSTR + ks * 32 + 8 * fq);
#pragma unroll
    for (int i = 0; i < 8; ++i)
#pragma unroll
      for (int j = 0; j < 4; ++j)
        acc[i][j] = VT ? mfma16(ta[i], tb[j], acc[i][j]) : mfma16(tb[j], ta[i], acc[i][j]);
  }
  __builtin_amdgcn_sched_group_barrier(0x100, 6, 0);
#pragma unroll
  for (int g = 0; g < 6; ++g) {
    __builtin_amdgcn_sched_group_barrier(0x008, 4, 0);
    __builtin_amdgcn_sched_group_barrier(0x100, 1, 0);
  }
  __builtin_amdgcn_sched_group_barrier(0x100, 6, 0);
  __builtin_amdgcn_sched_group_barrier(0x008, 8, 0);
#pragma unroll
  for (int g = 0; g < 6; ++g) {
    __builtin_amdgcn_sched_group_barrier(0x008, 4, 0);
    __builtin_amdgcn_sched_group_barrier(0x100, 1, 0);
  }
  __builtin_amdgcn_sched_group_barrier(0x008, 8, 0);
}

template <bool VT>
DI void gemm_mainloop(f32x4 (&acc)[8][4], const char* abase, const char* bbase, unsigned toff, u16* sA, u16* sB, int loff, int wm, int wn, int fr, int fq) {
  const __amdgpu_buffer_rsrc_t ra_rs = __builtin_amdgcn_make_buffer_rsrc((void*)abase, (short)0, 256 * 2048, 0x00020000);
  const __amdgpu_buffer_rsrc_t rb_rs = __builtin_amdgcn_make_buffer_rsrc((void*)bbase, (short)0, 128 * 2048, 0x00020000);
  u32x4 ra[8], rb[4];
#pragma unroll
  for (int i = 0; i < 8; ++i) ra[i] = __builtin_amdgcn_raw_buffer_load_b128(ra_rs, (int)toff, i * 65536, 0);
#pragma unroll
  for (int i = 0; i < 4; ++i) rb[i] = __builtin_amdgcn_raw_buffer_load_b128(rb_rs, (int)toff, i * 65536, 0);
#pragma unroll 1
  for (int kt = 0; kt < 16; ++kt) {
    __syncthreads();
#pragma unroll
    for (int i = 0; i < 8; ++i) *(u32x4*)(sA + loff + i * 32 * GSTR) = ra[i];
#pragma unroll
    for (int i = 0; i < 4; ++i) *(u32x4*)(sB + loff + i * 32 * GSTR) = rb[i];
    __syncthreads();
    if (kt + 1 < 16) {
      const int ko = (kt + 1) * 128;
#pragma unroll
      for (int i = 0; i < 8; ++i) ra[i] = __builtin_amdgcn_raw_buffer_load_b128(ra_rs, (int)toff, i * 65536 + ko, 0);
#pragma unroll
      for (int i = 0; i < 4; ++i) rb[i] = __builtin_amdgcn_raw_buffer_load_b128(rb_rs, (int)toff, i * 65536 + ko, 0);
    }
    __builtin_amdgcn_s_setprio(1);
    gemm_kslab<VT>(acc, sA, sB, wm, wn, fr, fq);
    __builtin_amdgcn_s_setprio(0);
  }
}

template <int EPI>
DI void gemm_tile(const Params& p, int layer, int mt, int nt, u16* sm, int wv) {
  const int tid = tid_now(wv), w = tid >> 6;
  int lane = tid & 63, fr = lane & 15, fq = lane >> 4;
  const u16* A = (EPI == 0) ? p.xg : p.y;
  const u16* Bt = (EPI == 0) ? p.wtin + (size_t)layer * DIN * 1024 : p.wtout + (size_t)layer * 1024 * 1024;
  const int m0 = mt * 256, n0 = nt * 128;
  const char* abase = (const char*)(A + (size_t)m0 * 1024);
  const char* bbase = (const char*)(Bt + (size_t)n0 * 1024);
  const unsigned toff = (unsigned)(tid >> 3) * 2048u + (unsigned)(tid & 7) * 16u;
  const int loff = (tid >> 3) * GSTR + (tid & 7) * 8;
  u16* sA = sm;
  u16* sB = sm + 256 * GSTR;
  f32x4 acc[8][4];
#pragma unroll
  for (int i = 0; i < 8; ++i)
#pragma unroll
    for (int j = 0; j < 4; ++j)
#pragma unroll
      for (int e = 0; e < 4; ++e) acc[i][j][e] = 0.f;

  bool vtile = false;
  if (EPI == 0) vtile = (nt == 4 || nt == 5 || nt == 13 || nt == 22 || nt == 23);
  int wm = w >> 1, wn = w & 1;

  if (EPI == 0 && vtile) { asm volatile("; v-tile main loop" ::: "memory"); gemm_mainloop<true>(acc, abase, bbase, toff, sA, sB, loff, wm, wn, fr, fq); }
  else { asm volatile("; main loop" ::: "memory"); gemm_mainloop<false>(acc, abase, bbase, toff, sA, sB, loff, wm, wn, fr, fq); }

  {
    const int t2 = tid_now(wv);
    const int l2 = t2 & 63, w2 = t2 >> 6;
    lane = l2; fr = l2 & 15; fq = l2 >> 4; wm = w2 >> 1; wn = w2 & 1;
  }
  if (EPI == 0) {
    const float* ssl = p.ss + (size_t)layer * MTOK;
    __syncthreads();
    u16* stg = sm + (wm * 2 + wn) * (128 * LSTR);
    if (!vtile) {
      const float qsc = (nt < 2) ? 0.17677669529663687f * LOG2E
                        : ((nt >= 8 && nt < 12) || nt == 18 || nt == 19) ? 0.125f * LOG2E : 1.f;
#pragma unroll
      for (int i = 0; i < 8; ++i) {
        const int m = m0 + wm * 128 + 16 * i + fr;
        const float rs = __builtin_amdgcn_rsqf(ssl[m] * (1.f / DM) + EPS) * qsc;
        u16* d = stg + (16 * i + fr) * LSTR + 4 * fq;
#pragma unroll
        for (int j = 0; j < 4; ++j) {
          u32x2 v = {pk2(acc[i][j][0] * rs, acc[i][j][1] * rs), pk2(acc[i][j][2] * rs, acc[i][j][3] * rs)};
          *(u32x2*)(d + 16 * j) = v;
        }
      }
      u16* gdst = p.proj + (size_t)(m0 + wm * 128) * DIN + n0 + wn * 64;
#pragma unroll
      for (int t = 0; t < 16; ++t) {
        const int c = lane + 64 * t, row = c >> 3, kc = c & 7;
        const u32x4 v = *(const u32x4*)(stg + row * LSTR + kc * 8);
        *(u32x4*)(gdst + (size_t)row * DIN + kc * 8) = v;
      }
    } else {
      const int vbase = (nt == 4) ? 0 : (nt == 5) ? 2 : (nt == 13) ? 4 : (nt == 22) ? 6 : 8;
      const int bb = m0 / SEQ, s0 = m0 % SEQ;
      constexpr int VSTR = 136;
#pragma unroll
      for (int i = 0; i < 8; ++i) {
        float rs[4];
#pragma unroll
        for (int e = 0; e < 4; ++e) rs[e] = __builtin_amdgcn_rsqf(ssl[m0 + wm * 128 + 16 * i + 4 * fq + e] * (1.f / DM) + EPS);
        const int pos = 16 * i + 8 * (fq & 1) + 4 * (fq >> 1);
#pragma unroll
        for (int j = 0; j < 4; ++j) {
          u32x2 v = {pk2(acc[i][j][0] * rs[0], acc[i][j][1] * rs[1]), pk2(acc[i][j][2] * rs[2], acc[i][j][3] * rs[3])};
          *(u32x2*)(stg + (16 * j + fr) * VSTR + pos) = v;
        }
      }
      u16* gdst = p.vt + ((size_t)(bb * NVH + vbase + wn) * 64) * SEQ + s0 + wm * 128;
#pragma unroll
      for (int t = 0; t < 16; ++t) {
        const int c = lane + 64 * t, row = c >> 4, kc = c & 15;
        const u32x4 v = *(const u32x4*)(stg + row * VSTR + kc * 8);
        *(u32x4*)(gdst + (size_t)row * SEQ + kc * 8) = v;
      }
    }
  } else {
    const bool has_next = (layer + 1 < DEPTH);
    float* ssn = p.ss + (size_t)(layer + 1) * MTOK;
    __syncthreads();
    float* stg = (float*)(sm + (wm * 2 + wn) * (128 * LSTR));
    const int kc = lane & 15;
#pragma unroll
    for (int hh = 0; hh < 2; ++hh) {
#pragma unroll
      for (int i2 = 0; i2 < 4; ++i2)
#pragma unroll
        for (int j = 0; j < 4; ++j)
          *(f32x4*)(stg + (16 * i2 + fr) * 68 + 16 * j + 4 * fq) = acc[4 * hh + i2][j];
      const size_t mrow0 = (size_t)(m0 + wm * 128 + 64 * hh);
      u16* xrow = p.xg + mrow0 * DM + n0 + wn * 64 + kc * 4;
      u16* x2row = (u16*)p.x2 + mrow0 * DM + n0 + wn * 64 + kc * 4;
      u32x2 xb[16];
#pragma unroll
      for (int t = 0; t < 16; ++t) xb[t] = __builtin_nontemporal_load((const u32x2*)(xrow + (size_t)((lane >> 4) + 4 * t) * DM));
#pragma unroll
      for (int t = 0; t < 16; ++t) {
        const int row = (lane >> 4) + 4 * t;
        const f32x4 a4 = *(const f32x4*)(stg + row * 68 + kc * 4);
        const float v0 = bflo(xb[t][0]) + a4[0], v1 = bfhi(xb[t][0]) + a4[1], v2 = bflo(xb[t][1]) + a4[2], v3 = bfhi(xb[t][1]) + a4[3];
        float sq = v0 * v0 + v1 * v1 + v2 * v2 + v3 * v3;
        u32x2 pv = {pk2(v0, v1), pk2(v2, v3)};
        if (has_next) *(u32x2*)(xrow + (size_t)row * DM) = pv;
        else *(u32x2*)(x2row + (size_t)row * DM) = pv;
        sq += shx(sq, lane, 1); sq += shx(sq, lane, 2); sq += shx(sq, lane, 4); sq += shx(sq, lane, 8);
        if (kc == 0) atomicAdd(ssn + mrow0 + row, sq);
      }
    }
  }
}

template <int MODE, int KS0, int NKS>
DI void qk_scores(f32x16& s0, f32x16& s1, const u16* Ks, const bf16x8 (&qf)[4], float sl2, int dl, float mref,
                  bool need_mask, int r, int h, int rs, const int (&lo)[4]) {
  asm volatile("" : "+v"(dl));
  const float nb = -sl2 * (float)dl - mref;
#pragma unroll
  for (int i = 0; i < 16; ++i) {
    const int ci = (i & 3) + 8 * (i >> 2);
    s0[i] = fmaf(sl2, (float)ci, nb);
    s1[i] = fmaf(sl2, (float)(ci + 32), nb);
  }
#pragma unroll
  for (int ks = 0; ks < NKS; ++ks) {
    bf16x8 k0 = ldsv(Ks + lo[KS0 + ks]);
    bf16x8 k1 = ldsv(Ks + 32 * rs + lo[KS0 + ks]);
    s0 = mfma(k0, qf[KS0 + ks], s0);
    s1 = mfma(k1, qf[KS0 + ks], s1);
  }
  if (need_mask) {
#pragma unroll
    for (int i = 0; i < 16; ++i) {
      const int ci = (i & 3) + 8 * (i >> 2);
      bool v0 = (MODE == 0) ? (ci <= dl) : (ci <= dl && ci > dl - 128);
      bool v1 = (MODE == 0) ? (ci + 32 <= dl) : (ci + 32 <= dl && ci + 32 > dl - 128);
      s0[i] = v0 ? s0[i] : -INFINITY;
      s1[i] = v1 ? s1[i] : -INFINITY;
    }
  }
}
template <int MODE, int KS0, int NKS>
DI void softmax_pv(const bf16x8 (&qf)[4], const u16* Ks, const u16* Vs, float& m, f32x16& ls, f32x16& o0, f32x16& o1,
                   float sl2, int dl, bool need_mask, bool first, int r, int h, int rs, const int (&lo)[4]) {
  f32x16 s0, s1;
  qk_scores<MODE, KS0, NKS>(s0, s1, Ks, qf, sl2, dl, m, need_mask, r, h, rs, lo);
  if (__any(first || !(ls[0] <= 1.0e12f))) {
    float tmax = -INFINITY;
#pragma unroll
    for (int i = 0; i < 16; ++i) tmax = fmaxf(tmax, fmaxf(s0[i], s1[i]));
    tmax = fmaxf(tmax, shx(tmax, r + 32 * h));
    const float lref = (ls[0] > 1.f) ? lg2(ls[0]) : 0.f;
    const float delta = first ? tmax : fmaxf(fmaxf(tmax, lref), 0.f);
    m += delta;
    const float alpha = ex2(-delta);
#pragma unroll
    for (int e = 0; e < 16; ++e) { o0[e] *= alpha; o1[e] *= alpha; ls[e] *= alpha; }
#pragma unroll
    for (int i = 0; i < 16; ++i) { s0[i] -= delta; s1[i] -= delta; }
  }
#pragma unroll
  for (int i = 0; i < 16; ++i) { s0[i] = ex2(s0[i]); s1[i] = ex2(s1[i]); }
  const u32x4 one4 = {0x3f803f80u, 0x3f803f80u, 0x3f803f80u, 0x3f803f80u};
  const bf16x8 ones = __builtin_bit_cast(bf16x8, one4);
#pragma unroll
  for (int kk = 0; kk < 4; ++kk) {
    const int s = kk & 1;
    unsigned u0, u1, u2, u3;
    if (kk < 2) {
      u0 = pk2(s0[8 * s], s0[8 * s + 1]); u1 = pk2(s0[8 * s + 2], s0[8 * s + 3]);
      u2 = pk2(s0[8 * s + 4], s0[8 * s + 5]); u3 = pk2(s0[8 * s + 6], s0[8 * s + 7]);
    } else {
      u0 = pk2(s1[8 * s], s1[8 * s + 1]); u1 = pk2(s1[8 * s + 2], s1[8 * s + 3]);
      u2 = pk2(s1[8 * s + 4], s1[8 * s + 5]); u3 = pk2(s1[8 * s + 6], s1[8 * s + 7]);
    }
    u32x4 uu = {u0, u1, u2, u3};
    bf16x8 pf = __builtin_bit_cast(bf16x8, uu);
    bf16x8 v0 = ldsv(Vs + lo[kk]);
    bf16x8 v1 = ldsv(Vs + 32 * rs + lo[kk]);
    o0 = mfma(v0, pf, o0);
    o1 = mfma(v1, pf, o1);
    ls = mfma(ones, pf, ls);
  }
}

DI void pv_frag_step(f32x16& s0, f32x16& s1, const u16* Vs, f32x16& o0, f32x16& o1, f32x4& ls, bf16x8 ones, int rs, const int (&lo)[4]) {
#pragma unroll
  for (int i = 0; i < 16; ++i) { s0[i] = ex2(s0[i]); s1[i] = ex2(s1[i]); }
#pragma unroll
  for (int kk = 0; kk < 4; ++kk) {
    const int s = kk & 1;
    unsigned u0, u1, u2, u3;
    if (kk < 2) {
      u0 = pk2(s0[8 * s], s0[8 * s + 1]); u1 = pk2(s0[8 * s + 2], s0[8 * s + 3]);
      u2 = pk2(s0[8 * s + 4], s0[8 * s + 5]); u3 = pk2(s0[8 * s + 6], s0[8 * s + 7]);
    } else {
      u0 = pk2(s1[8 * s], s1[8 * s + 1]); u1 = pk2(s1[8 * s + 2], s1[8 * s + 3]);
      u2 = pk2(s1[8 * s + 4], s1[8 * s + 5]); u3 = pk2(s1[8 * s + 6], s1[8 * s + 7]);
    }
    u32x4 uu = {u0, u1, u2, u3};
    bf16x8 pf = __builtin_bit_cast(bf16x8, uu);
    bf16x8 v0 = ldsv(Vs + lo[kk]);
    bf16x8 v1 = ldsv(Vs + 32 * rs + lo[kk]);
    o0 = mfma(v0, pf, o0);
    o1 = mfma(v1, pf, o1);
    ls = mfma16(ones, pf, ls);
  }
}
DI void mask_causal(f32x16& s0, f32x16& s1, int dl) {
#pragma unroll
  for (int i = 0; i < 16; ++i) {
    const int ci = (i & 3) + 8 * (i >> 2);
    s0[i] = (ci <= dl) ? s0[i] : -INFINITY;
    s1[i] = (ci + 32 <= dl) ? s1[i] : -INFINITY;
  }
}
DI float bperm(float v, int srclane) { return __int_as_float(__builtin_amdgcn_ds_bpermute(srclane << 2, __float_as_int(v))); }
DI float own_rowsum(const f32x4& ls, int r) {
  const float a = bperm(ls[0], r & 15), b = bperm(ls[1], r & 15);
  return (r >> 4) ? b : a;
}
DI bf16x8 rowsum_ones(int lane) {
  const int fr16 = lane & 15, g = lane >> 4;
  const unsigned w = (fr16 < 2 && fr16 == (g & 1)) ? 0x3f803f80u : 0u;
  const u32x4 v = {w, w, w, w};
  return __builtin_bit_cast(bf16x8, v);
}
DI void diff_softmax_pv(const bf16x8 (&qf)[4], const u16* Ks, const u16* Vs, float& m, f32x4& ls0, f32x4& ls1, bf16x8 ones,
                        f32x16 (&o)[2][2], float sl2, int dl, bool need_mask, bool first, int r, int h, int rs, const int (&lo)[4]) {
  f32x16 b0, b1;
  const float nb = -sl2 * (float)dl - m;
#pragma unroll
  for (int i = 0; i < 16; ++i) {
    const int ci = (i & 3) + 8 * (i >> 2);
    b0[i] = fmaf(sl2, (float)ci, nb);
    b1[i] = fmaf(sl2, (float)(ci + 32), nb);
  }
  {
    __builtin_amdgcn_s_setprio(1);
    f32x16 s0 = mfma(ldsv(Ks + lo[0]), qf[0], b0);
    f32x16 s1 = mfma(ldsv(Ks + 32 * rs + lo[0]), qf[0], b1);
    s0 = mfma(ldsv(Ks + lo[1]), qf[1], s0);
    s1 = mfma(ldsv(Ks + 32 * rs + lo[1]), qf[1], s1);
    __builtin_amdgcn_s_setprio(0);
    if (need_mask) mask_causal(s0, s1, dl);
    if (__any(first || !(ls0[0] <= 1.0e12f) || !(ls0[1] <= 1.0e12f) || !(ls1[0] <= 1.0e12f) || !(ls1[1] <= 1.0e12f))) {
      float tmax = -INFINITY;
#pragma unroll
      for (int i = 0; i < 16; ++i) tmax = fmaxf(tmax, fmaxf(s0[i], s1[i]));
      tmax = fmaxf(tmax, shx(tmax, r + 32 * h));
      const float lmx = fmaxf(own_rowsum(ls0, r), own_rowsum(ls1, r));
      const float lref = (lmx > 1.f) ? lg2(lmx) : 0.f;
      const float delta = first ? tmax : fmaxf(fmaxf(tmax, lref), 0.f);
      m += delta;
      const float alpha = ex2(-delta);
      const float alpha_hi = shx(alpha, r + 32 * h, 16);
      ls0[0] *= alpha; ls0[1] *= alpha_hi; ls1[0] *= alpha; ls1[1] *= alpha_hi;
#pragma unroll
      for (int e = 0; e < 16; ++e) {
        o[0][0][e] *= alpha; o[0][1][e] *= alpha; o[1][0][e] *= alpha; o[1][1][e] *= alpha;
        s0[e] -= delta; s1[e] -= delta; b0[e] -= delta; b1[e] -= delta;
      }
    }
    pv_frag_step(s0, s1, Vs, o[0][0], o[0][1], ls0, ones, rs, lo);
  }
  {
    f32x16 s0 = mfma(ldsv(Ks + lo[2]), qf[2], b0);
    f32x16 s1 = mfma(ldsv(Ks + 32 * rs + lo[2]), qf[2], b1);
    s0 = mfma(ldsv(Ks + lo[3]), qf[3], s0);
    s1 = mfma(ldsv(Ks + 32 * rs + lo[3]), qf[3], s1);
    if (need_mask) mask_causal(s0, s1, dl);
    pv_frag_step(s0, s1, Vs, o[1][0], o[1][1], ls1, ones, rs, lo);
  }
}

DI void stick_pv(f32x16& s0, f32x16& s1, float& R, f32x16& o0, f32x16& o1, const u16* Vs, int dl,
                 bool need_mask, int r, int h) {
  float x[32];
#pragma unroll
  for (int t = 0; t < 2; ++t)
#pragma unroll
    for (int i = 0; i < 16; ++i) {
      const int ci = 32 * t + (i & 3) + 8 * (i >> 2);
      float a = t ? s1[i] : s0[i];
      float z = __builtin_amdgcn_fmed3f(a, -126.f, 126.f);
      float e = ex2(-z);
      float lb = -lg2(1.f + e);
      float xi = lb - z;
      if (need_mask) {
        bool valid = (ci < dl);
        xi = valid ? xi : 0.f;
        lb = valid ? lb : -INFINITY;
      }
      x[16 * t + i] = xi;
      if (t) s1[i] = lb; else s0[i] = lb;
    }
  float gs[8], pg[8], pr[8];
#pragma unroll
  for (int g = 0; g < 8; ++g) {
    gs[g] = (x[4 * g] + x[4 * g + 1]) + (x[4 * g + 2] + x[4 * g + 3]);
    pg[g] = shx(gs[g], r + 32 * h);
    pr[g] = gs[g] + pg[g];
  }
  float suf = 0.f;
#pragma unroll
  for (int g = 7; g >= 0; --g) {
    float base = R + suf + (h == 0 ? pg[g] : 0.f);
    float t3 = base, t2 = t3 + x[4 * g + 3], t1 = t2 + x[4 * g + 2], t0 = t1 + x[4 * g + 1];
    const int i = 4 * (g & 3);
    if (g >= 4) {
      s1[i] = ex2(s1[i] + t0); s1[i + 1] = ex2(s1[i + 1] + t1); s1[i + 2] = ex2(s1[i + 2] + t2); s1[i + 3] = ex2(s1[i + 3] + t3);
    } else {
      s0[i] = ex2(s0[i] + t0); s0[i + 1] = ex2(s0[i + 1] + t1); s0[i + 2] = ex2(s0[i + 2] + t2); s0[i + 3] = ex2(s0[i + 3] + t3);
    }
    suf += pr[g];
  }
  R += suf;
#pragma unroll
  for (int kk = 0; kk < 4; ++kk) {
    const int s = kk & 1;
    unsigned u0, u1, u2, u3;
    if (kk < 2) {
      u0 = pk2(s0[8 * s], s0[8 * s + 1]); u1 = pk2(s0[8 * s + 2], s0[8 * s + 3]);
      u2 = pk2(s0[8 * s + 4], s0[8 * s + 5]); u3 = pk2(s0[8 * s + 6], s0[8 * s + 7]);
    } else {
      u0 = pk2(s1[8 * s], s1[8 * s + 1]); u1 = pk2(s1[8 * s + 2], s1[8 * s + 3]);
      u2 = pk2(s1[8 * s + 4], s1[8 * s + 5]); u3 = pk2(s1[8 * s + 6], s1[8 * s + 7]);
    }
    u32x4 uu = {u0, u1, u2, u3};
    bf16x8 pf = __builtin_bit_cast(bf16x8, uu);
    bf16x8 v0 = ldsv(Vs + r * LSTR + kk * 16 + 8 * h);
    bf16x8 v1 = ldsv(Vs + (32 + r) * LSTR + kk * 16 + 8 * h);
    o0 = mfma(v0, pf, o0);
    o1 = mfma(v1, pf, o1);
  }
}

DI void load_gate_rows(u32x2 (&gv)[8], const u16* grow0, int lane) {
#pragma unroll
  for (int t = 0; t < 8; ++t) gv[t] = __builtin_nontemporal_load((const u32x2*)(grow0 + (size_t)((lane >> 4) + 4 * t) * DIN + (lane & 15) * 4));
}
DI void store_y(const f32x16& oa, const f32x16& ob, float mult, const float* sg, const u32x2 (&gv)[8], u16* yrow0, float* stg,
                int lane, int r, int h) {
#pragma unroll
  for (int dt = 0; dt < 2; ++dt)
#pragma unroll
    for (int g = 0; g < 4; ++g) {
      f32x4 v;
      v[0] = (dt ? ob[4 * g] : oa[4 * g]) * mult; v[1] = (dt ? ob[4 * g + 1] : oa[4 * g + 1]) * mult;
      v[2] = (dt ? ob[4 * g + 2] : oa[4 * g + 2]) * mult; v[3] = (dt ? ob[4 * g + 3] : oa[4 * g + 3]) * mult;
      *(f32x4*)(stg + r * 68 + 32 * dt + 8 * g + 4 * h) = v;
    }
  const int kc = lane & 15;
  f32x4 sv = {1.f, 1.f, 1.f, 1.f};
  if (sg) sv = *(const f32x4*)(sg + kc * 4);
#pragma unroll
  for (int t = 0; t < 8; ++t) {
    const int row = (lane >> 4) + 4 * t;
    const f32x4 v = *(const f32x4*)(stg + row * 68 + kc * 4);
    float y0 = v[0] * sv[0] * silu(bflo(gv[t][0]));
    float y1 = v[1] * sv[1] * silu(bfhi(gv[t][0]));
    float y2 = v[2] * sv[2] * silu(bflo(gv[t][1]));
    float y3 = v[3] * sv[3] * silu(bfhi(gv[t][1]));
    u32x2 yo = {pk2(y0, y1), pk2(y2, y3)};
    *(u32x2*)(yrow0 + (size_t)row * DM + kc * 4) = yo;
  }
}

DI void attn_item_A(const Params& p, int layer, int b, int head, int qb, u16* sm, float lam, float lam_init, int wv) {
  const int tid = tid_now(wv), lane = tid & 63, w = tid >> 6, r = lane & 31, h = lane >> 5;
  const int qsub = w & 1, kh = w >> 1;
  const int q0 = qb * 64, q0w = q0 + 32 * qsub, qpos = q0w + r;
  const int qoff = head * 64, koff = 256 + head * 64, vh = head, goff = 768 + head * 64, yoff = head * 64;
  const u16* projb = p.proj + (size_t)b * SEQ * DIN;
  u16* Kb0 = sm + kh * (4 * 64 * 64);

  bf16x8 qf[4];
#pragma unroll
  for (int ks = 0; ks < 4; ++ks) qf[ks] = __builtin_nontemporal_load((const bf16x8*)(projb + (size_t)qpos * DIN + qoff + 16 * ks + 8 * h));
  const float sl2 = exp2f(-8.f * (float)(9 + head) / 12.f) * LOG2E;
  int lo[4];
#pragma unroll
  for (int c = 0; c < 4; ++c) lo[c] = r * 64 + (((2 * c + h) ^ ((r >> 1) & 7)) * 8);

  const int t7 = tid & 127, wp = t7 >> 6;
  const int csrc = (lane & 7) ^ ((4 * wp + (lane >> 4)) & 7);
  const int row0 = wp * 8 + (lane >> 3);
  const u16* kg = projb + koff + csrc * 8;
  const u16* vg = p.vt + ((size_t)(b * NVH + vh) * 64) * SEQ + csrc * 8;

  float zf = 0.f;
  asm volatile("" : "+v"(zf));
  f32x16 o[2][2];
#pragma unroll
  for (int a = 0; a < 2; ++a)
#pragma unroll
    for (int d = 0; d < 2; ++d)
#pragma unroll
      for (int e = 0; e < 16; ++e) o[a][d][e] = zf;
  float m0 = 0.f, m1 = 0.f;
  f32x4 ls0 = {zf, zf, zf, zf}, ls1 = {zf, zf, zf, zf};
  const bf16x8 ones = rowsum_ones(lane);
  bool started = false;

  const int npairs = (qb >> 1) + 1;
  const int T0 = 2 * (npairs - 1) + kh;
  const bool v0 = (T0 <= qb);
  auto dma_tile = [&](int T, int c) {
    const int k0 = 64 * T;
    u16* Kd = Kb0 + c * (2 * 64 * 64) + wp * (8 * 64);
#pragma unroll
    for (int i = 0; i < 4; ++i) {
      __builtin_amdgcn_global_load_lds((const unsigned*)(kg + (size_t)(k0 + row0 + 16 * i) * DIN), (unsigned*)(Kd + i * 16 * 64), 16, 0, 0);
      __builtin_amdgcn_global_load_lds((const unsigned*)(vg + (size_t)(row0 + 16 * i) * SEQ + k0), (unsigned*)(Kd + 64 * 64 + i * 16 * 64), 16, 0, 0);
    }
  };
  if (v0) dma_tile(T0, 0);
  asm volatile("" :: "v"(qf[0]), "v"(qf[1]), "v"(qf[2]), "v"(qf[3]));
  asm volatile("s_waitcnt vmcnt(0)" ::: "memory");
  __syncthreads();
  for (int j = 0; j < npairs; ++j) {
    if (j + 1 < npairs) dma_tile(T0 - 2 * (j + 1), (j + 1) & 1);
    if (j > 0 || v0) {
      const int T = T0 - 2 * j;
      const u16* Ks = Kb0 + (j & 1) * (2 * 64 * 64);
      const u16* Vs = Ks + 64 * 64;
      const int k0 = 64 * T;
      const bool need_mask = (T == qb);
      const int dl = qpos - k0 - 4 * h;
      diff_softmax_pv(qf, Ks, Vs, m0, ls0, ls1, ones, o, sl2, dl, need_mask, !started, r, h, 64, lo);
      m1 = m0;
      started = true;
    }
    asm volatile("s_waitcnt vmcnt(0)" ::: "memory");
    __syncthreads();
  }

  if (!started) { m0 = -INFINITY; m1 = -INFINITY; }
  float l0 = own_rowsum(ls0, r), l1 = own_rowsum(ls1, r);
  u32x2 gate[8];
  if (kh == 0) load_gate_rows(gate, projb + (size_t)q0w * DIN + goff, lane);
  float* cb = (float*)sm + (size_t)qsub * 68 * 64 + lane;
  if (kh == 1) {
#pragma unroll
    for (int a = 0; a < 2; ++a)
#pragma unroll
      for (int d = 0; d < 2; ++d)
#pragma unroll
        for (int e = 0; e < 16; ++e) cb[((a * 2 + d) * 16 + e) * 64] = o[a][d][e];
    cb[64 * 64] = m0; cb[65 * 64] = l0; cb[66 * 64] = m1; cb[67 * 64] = l1;
  }
  __syncthreads();
  if (kh == 0) {
    {
      const float mb = cb[64 * 64], lb = cb[65 * 64];
      const float mn = fmaxf(m0, mb), fa = ex2(m0 - mn), fb = ex2(mb - mn);
      l0 = l0 * fa + lb * fb;
#pragma unroll
      for (int d = 0; d < 2; ++d)
#pragma unroll
        for (int e = 0; e < 16; ++e) o[0][d][e] = o[0][d][e] * fa + cb[((0 * 2 + d) * 16 + e) * 64] * fb;
    }
    {
      const float mb = cb[66 * 64], lb = cb[67 * 64];
      const float mn = fmaxf(m1, mb), fa = ex2(m1 - mn), fb = ex2(mb - mn);
      l1 = l1 * fa + lb * fb;
#pragma unroll
      for (int d = 0; d < 2; ++d)
#pragma unroll
        for (int e = 0; e < 16; ++e) o[1][d][e] = o[1][d][e] * fa + cb[((1 * 2 + d) * 16 + e) * 64] * fb;
    }
    const float inv0 = 1.f / l0, inv1 = lam / l1;
    float sq = 0.f;
#pragma unroll
    for (int dt = 0; dt < 2; ++dt)
#pragma unroll
      for (int e = 0; e < 16; ++e) {
        float v = o[0][dt][e] * inv0 - o[1][dt][e] * inv1;
        o[0][dt][e] = v;
        sq += v * v;
      }
    sq += shx(sq, lane);
    const float mult = __builtin_amdgcn_rsqf(sq * (1.f / 64.f) + EPS) * (1.f - lam_init);
    store_y(o[0][0], o[0][1], mult, p.subln_g + layer * 64, gate,
            p.y + ((size_t)b * SEQ + q0w) * DM + yoff, (float*)sm + 9216 + w * 2176, lane, r, h);
  }
}

template <int MODE>
DI void attn_item(const Params& p, int layer, int b, int head, int qblk, u16* sm, volatile LAS int* s_done_, int wv) {
  const int tid = tid_now(wv), lane = tid & 63, w = tid >> 6, r = lane & 31, h = lane >> 5;
  const int q0 = qblk * 128, q0w = q0 + 32 * w, qpos = q0w + r;
  int qoff, koff, vh, goff, yoff;
  if (MODE == 1) { qoff = 1024 + head * 64; koff = 1536 + (head >> 2) * 64; vh = 4 + (head >> 2); goff = 1792 + head * 64; yoff = 256 + head * 64; }
  else { qoff = 2304 + head * 64; koff = 2560 + head * 64; vh = 6 + head; goff = 3072 + head * 64; yoff = 768 + head * 64; }
  const u16* projb = p.proj + (size_t)b * SEQ * DIN;
  u16* Ks = sm;
  u16* Vs = sm + 64 * LSTR;

  bf16x8 qf[4];
#pragma unroll
  for (int ks = 0; ks < 4; ++ks) qf[ks] = __builtin_nontemporal_load((const bf16x8*)(projb + (size_t)qpos * DIN + qoff + 16 * ks + 8 * h));

  float sl2 = 0.f;
  if (MODE == 1) sl2 = exp2f(-8.f * (float)(1 + head) / 12.f) * LOG2E;
  int lo[4];
#pragma unroll
  for (int c = 0; c < 4; ++c) lo[c] = r * LSTR + c * 16 + 8 * h;

  int it0 = 0, ntiles;
  if (MODE == 1) { ntiles = 4; it0 = (qblk == 0) ? 2 : 0; }
  else ntiles = 2 * (qblk + 1);

  const u16* kg = projb + koff + (tid & 7) * 8;
  const u16* vg = p.vt + ((size_t)(b * NVH + vh) * 64) * SEQ + (tid & 7) * 8;
  const int row0 = tid >> 3;
  const int loff = row0 * LSTR + (tid & 7) * 8;

  f32x16 o[2];
#pragma unroll
  for (int d = 0; d < 2; ++d)
#pragma unroll
    for (int e = 0; e < 16; ++e) o[d][e] = 0.f;
  float m0 = -INFINITY, R = 0.f;
  f32x16 ls0;
#pragma unroll
  for (int e = 0; e < 16; ++e) ls0[e] = (MODE == 1) ? 1.f : 0.f;
  if (MODE == 1) m0 = p.sinks[layer * 8 + head] * LOG2E;
  int wdone = 0;
  volatile LAS int* s_done = lds_fresh(s_done_);
  if (MODE == 2 && lane == 0) s_done[w] = 0;

  auto tile_k0 = [&](int it) -> int {
    if (MODE == 1) return q0 - 128 + 64 * it;
    return 64 * (ntiles - 1 - it);
  };
  u32x2 gate[8];
  load_gate_rows(gate, projb + (size_t)q0w * DIN + goff, lane);
  bool stop = false;
  for (int base = 0; base < ntiles && !stop; base += 4) {
    u32x4 rk[4][2], rv[4][2];
#pragma unroll
    for (int c = 0; c < 4; ++c) {
      const int it = base + c;
      if (it >= it0 && it < ntiles) {
        const int k0 = tile_k0(it);
#pragma unroll
        for (int i = 0; i < 2; ++i) {
          rk[c][i] = *(const u32x4*)(kg + (size_t)(k0 + row0 + 32 * i) * DIN);
          rv[c][i] = *(const u32x4*)(vg + (size_t)(row0 + 32 * i) * SEQ + k0);
        }
      }
    }
    __syncthreads();
    if (MODE == 2 && base > 0 && (s_done[0] & s_done[1] & s_done[2] & s_done[3])) { stop = true; }
    if (!stop) {
#pragma unroll
      for (int c = 0; c < 4; ++c) {
        const int it = base + c;
        if (it >= it0 && it < ntiles) {
#pragma unroll
          for (int i = 0; i < 2; ++i) {
            *(u32x4*)(Ks + c * (2 * 64 * LSTR) + loff + i * 32 * LSTR) = rk[c][i];
            *(u32x4*)(Vs + c * (2 * 64 * LSTR) + loff + i * 32 * LSTR) = rv[c][i];
          }
        }
      }
    }
    __syncthreads();
    if (!stop) {
#pragma unroll
      for (int c = 0; c < 4; ++c) {
        const int it = base + c;
        if (it >= it0 && it < ntiles) {
          const u16* Kc = Ks + c * (2 * 64 * LSTR);
          const u16* Vc = Vs + c * (2 * 64 * LSTR);
          const int k0 = tile_k0(it);
          bool skip, need_mask;
          if (MODE == 1) { skip = (k0 > q0w + 31) || (k0 + 63 < q0w - 127); need_mask = true; }
          else { skip = (k0 >= q0w + 31) || wdone; need_mask = (k0 + 63 >= q0w); }
          if (!skip) {
            const int dl = qpos - k0 - 4 * h;
            if (MODE == 1) {
              softmax_pv<1, 0, 4>(qf, Kc, Vc, m0, ls0, o[0], o[1], sl2, dl, need_mask, false, r, h, LSTR, lo);
            } else {
              f32x16 sa[2];
#pragma unroll
              for (int e = 0; e < 16; ++e) { sa[0][e] = 0.f; sa[1][e] = 0.f; }
#pragma unroll
              for (int t = 0; t < 2; ++t)
#pragma unroll
                for (int ks = 0; ks < 4; ++ks) {
                  bf16x8 kf = ldsv(Kc + (32 * t + r) * LSTR + ks * 16 + 8 * h);
                  sa[t] = mfma(kf, qf[ks], sa[t]);
                }
              stick_pv(sa[0], sa[1], R, o[0], o[1], Vc, dl, need_mask, r, h);
              wdone = __all(R < -160.f) ? 1 : 0;
            }
          }
        }
      }
      if (MODE == 2 && lane == 0) s_done[w] = wdone;
    }
  }
  __syncthreads();

  float inv = 1.f;
  if (MODE == 1) inv = 1.f / ls0[0];
  store_y(o[0], o[1], inv, nullptr, gate, p.y + ((size_t)b * SEQ + q0w) * DM + yoff,
          (float*)sm + 9216 + w * 2176, lane, r, h);
}

DI void attn_item_B2(const Params& p, int layer, int b, int head0, int qblk, u16* sm, int wv) {
  asm volatile("" : "+s"(head0));
  const int tid = tid_now(wv), lane = tid & 63, w = tid >> 6, r = lane & 31, h = lane >> 5;
  const int q0 = qblk * 128, q0w = q0 + 32 * w, qpos = q0w + r;
  const int koff = 1536 + (head0 >> 2) * 64, vh = 4 + (head0 >> 2);
  const u16* projb = p.proj + (size_t)b * SEQ * DIN;
  u16* Ks = sm;
  u16* Vs = sm + 64 * LSTR;
  const int it0 = (qblk == 0) ? 2 : 0;

  bf16x8 qf[2][4];
  u32x2 gate[2][8];
#pragma unroll
  for (int hh = 0; hh < 2; ++hh) {
#pragma unroll
    for (int ks = 0; ks < 4; ++ks)
      qf[hh][ks] = __builtin_nontemporal_load((const bf16x8*)(projb + (size_t)qpos * DIN + 1024 + (head0 + hh) * 64 + 16 * ks + 8 * h));
    load_gate_rows(gate[hh], projb + (size_t)q0w * DIN + 1792 + (head0 + hh) * 64, lane);
  }
  int lo[4];
#pragma unroll
  for (int c = 0; c < 4; ++c) lo[c] = r * LSTR + c * 16 + 8 * h;

  const u16* kg = projb + koff + (tid & 7) * 8;
  const u16* vg = p.vt + ((size_t)(b * NVH + vh) * 64) * SEQ + (tid & 7) * 8;
  const int row0 = tid >> 3;
  const int loff = row0 * LSTR + (tid & 7) * 8;
  {
    u32x4 rk[4][2], rv[4][2];
#pragma unroll
    for (int c = 0; c < 4; ++c) {
      if (c >= it0) {
        const int k0 = q0 - 128 + 64 * c;
#pragma unroll
        for (int i = 0; i < 2; ++i) {
          rk[c][i] = *(const u32x4*)(kg + (size_t)(k0 + row0 + 32 * i) * DIN);
          rv[c][i] = *(const u32x4*)(vg + (size_t)(row0 + 32 * i) * SEQ + k0);
        }
      }
    }
    __syncthreads();
#pragma unroll
    for (int c = 0; c < 4; ++c) {
      if (c >= it0) {
#pragma unroll
        for (int i = 0; i < 2; ++i) {
          *(u32x4*)(Ks + c * (2 * 64 * LSTR) + loff + i * 32 * LSTR) = rk[c][i];
          *(u32x4*)(Vs + c * (2 * 64 * LSTR) + loff + i * 32 * LSTR) = rv[c][i];
        }
      }
    }
    __syncthreads();
  }
  float zf = 0.f, onef = 1.f;
  asm volatile("" : "+v"(zf), "+v"(onef));
  f32x16 o[2][2], ls[2];
  float mref[2];
#pragma unroll
  for (int hh = 0; hh < 2; ++hh) {
    const int head = head0 + hh;
    const float sl2 = exp2f(-8.f * (float)(1 + head) / 12.f) * LOG2E;
#pragma unroll
    for (int e = 0; e < 16; ++e) { o[hh][0][e] = zf; o[hh][1][e] = zf; ls[hh][e] = onef; }
    mref[hh] = p.sinks[layer * 8 + head] * LOG2E;
#pragma unroll
    for (int c = 0; c < 4; ++c) {
      if (c >= it0) {
        const int k0 = q0 - 128 + 64 * c;
        const bool skip = (k0 > q0w + 31) || (k0 + 63 < q0w - 127);
        if (!skip) {
          const int dl = qpos - k0 - 4 * h;
          softmax_pv<1, 0, 4>(qf[hh], Ks + c * (2 * 64 * LSTR), Vs + c * (2 * 64 * LSTR), mref[hh], ls[hh], o[hh][0], o[hh][1],
                              sl2, dl, true, false, r, h, LSTR, lo);
        }
      }
    }
  }
  __syncthreads();
#pragma unroll
  for (int hh = 0; hh < 2; ++hh)
    store_y(o[hh][0], o[hh][1], 1.f / ls[hh][0], nullptr, gate[hh], p.y + ((size_t)b * SEQ + q0w) * DM + 256 + (head0 + hh) * 64,
            (float*)sm + 9216 + w * 2176, lane, r, h);
}

__global__ void __launch_bounds__(256, 2) hymba_mega(Params p) {
  cg::grid_group grid = cg::this_grid();
  __shared__ __attribute__((aligned(16))) u16 sm[SMEM_U16];
  __shared__ int s_item;
  __shared__ int s_done[4];
  const int wv = __builtin_amdgcn_readfirstlane((int)threadIdx.x >> 6);
  const int bid = blockIdx.x, nb = gridDim.x;
  const int xcd = bid & 7, lb = bid >> 3, nxb = nb >> 3;
  __shared__ __attribute__((aligned(16))) unsigned xb_words[4];
  if (tid_now(wv) == 0) { xb_words[0] = 0u; xb_words[1] = 0u; xb_words[2] = 0u; xb_words[3] = 0u; }
  __syncthreads();
  const XcdBarrier gb = xcd_barrier_post(p.bar, (volatile LAS unsigned*)xb_words, wv);
  if (p.never) grid.sync();

  for (int rep = 0; rep < REP_PREP; ++rep) { phase_prep(p, sm, wv); xcd_barrier(gb); }

  for (int layer = 0; layer < DEPTH; ++layer) {
    for (int rep = 0; rep < REP_G0; ++rep) {
      for (int u = lb; u < 8 * 26; u += nxb) gemm_tile<0>(p, layer, xcd + 8 * (u & 7), u >> 3, sm, wv);
      xcd_barrier(gb);
    }

    {
      const float lam_init = 0.8f - 0.6f * expf(-0.3f * (float)layer);
      float d1 = 0.f, d2 = 0.f;
      for (int i = 0; i < 32; ++i) {
        d1 += p.lq1[layer * 32 + i] * p.lk1[layer * 32 + i];
        d2 += p.lq2[layer * 32 + i] * p.lk2[layer * 32 + i];
      }
      const float lam = expf(d1) - expf(d2) + lam_init;
      for (int rep = 0; rep < REP_ATT; ++rep) {
      if (rep) xcd_barrier(gb);
      unsigned* qctr = p.ctr + (rep * 2 + layer) * 8 + xcd;
      for (;;) {
        __syncthreads();
        volatile LAS int* sit = lds_fresh((volatile LAS int*)&s_item);
        if (tid_now(wv) == 0) *sit = (int)atomicAdd(qctr, 1u);
        __syncthreads();
        const int item = *sit;
        if (item >= N_ITEMS_XCD) break;
        const int slot = (item < 128) ? 0 : (item < 192) ? 1 : 3, per = (item < 128) ? 0 : (item < 192) ? item - 128 : item - 192;
        if (slot == 0 || slot == 2) {
          const int ia = item;
          if (!(rep && (0 < REP_LO || 128 > REP_HI)))
          attn_item_A(p, layer, xcd >> 2, xcd & 3, 127 - ia, sm, lam, lam_init, wv);
        } else if (slot == 1) {
          if (!(rep && (128 < REP_LO || 192 > REP_HI)))
          attn_item_B2(p, layer, (2 * xcd) >> 3, (2 * xcd) & 7, 63 - per, sm, wv);
        } else {
          if (!(rep && (192 < REP_LO || 256 > REP_HI)))
          attn_item<2>(p, layer, xcd >> 2, xcd & 3, 63 - per, sm, (volatile LAS int*)s_done, wv);
        }
      }
      }
    }
    xcd_barrier(gb);

    for (int u = lb; u < 8 * 8; u += nxb) gemm_tile<1>(p, layer, xcd + 8 * (u & 7), u >> 3, sm, wv);
    xcd_barrier(gb);
  }

  {
    const int tid = tid_now(wv), lane = tid & 63;
    const float* ssf = p.ss + (size_t)DEPTH * MTOK;
    f32x4 gv[4];
#pragma unroll
    for (int j = 0; j < 4; ++j) gv[j] = *(const f32x4*)(p.final_g + j * 256 + lane * 4);
    for (int row0 = (bid * 4 + (tid >> 6)) * 4; row0 < MTOK; row0 += nb * 16) {
      f32x4 xv[4][4];
      float rs[4];
#pragma unroll
      for (int q = 0; q < 4; ++q) {
        rs[q] = ssf[row0 + q];
#pragma unroll
        for (int j = 0; j < 4; ++j) {
          const u32x2 xb = __builtin_nontemporal_load((const u32x2*)((const u16*)p.x2 + (size_t)(row0 + q) * DM + j * 256 + lane * 4));
          xv[q][j][0] = bflo(xb[0]); xv[q][j][1] = bfhi(xb[0]); xv[q][j][2] = bflo(xb[1]); xv[q][j][3] = bfhi(xb[1]);
        }
      }
#pragma unroll
      for (int q = 0; q < 4; ++q) {
        const float rq = __builtin_amdgcn_rsqf(rs[q] * (1.f / DM) + EPS);
#pragma unroll
        for (int j = 0; j < 4; ++j) {
          f32x4 v = xv[q][j];
          v[0] *= rq * gv[j][0]; v[1] *= rq * gv[j][1]; v[2] *= rq * gv[j][2]; v[3] *= rq * gv[j][3];
          __builtin_nontemporal_store(v, (f32x4*)(p.out + (size_t)(row0 + q) * DM + j * 256 + lane * 4));
        }
      }
    }
  }
}

extern "C" void kernel_launch(void* const* d_in, const int* in_sizes, int n_in, void* d_out, int out_size, void* d_ws,
                              size_t ws_size, hipStream_t stream) {
  static int grid_blocks = 0;
  if (!grid_blocks) {
    int dev = 0, cus = 0, per_cu = 0;
    hipGetDevice(&dev);
    hipDeviceGetAttribute(&cus, hipDeviceAttributeMultiprocessorCount, dev);
    hipOccupancyMaxActiveBlocksPerMultiprocessor(&per_cu, hymba_mega, 256, 0);
    if (per_cu > 2) per_cu = 2;
    if (per_cu < 1) per_cu = 1;
    grid_blocks = cus * per_cu;
    grid_blocks -= grid_blocks % 8;
  }
  Params p{};
  p.x = (const float*)d_in[0]; p.norm_g = (const float*)d_in[1]; p.w_in = (const float*)d_in[2];
  p.lq1 = (const float*)d_in[3]; p.lk1 = (const float*)d_in[4]; p.lq2 = (const float*)d_in[5];
  p.lk2 = (const float*)d_in[6]; p.subln_g = (const float*)d_in[7]; p.sinks = (const float*)d_in[8];
  p.w_out = (const float*)d_in[9]; p.final_g = (const float*)d_in[10];
  p.out = (float*)d_out;
  char* ws = (char*)d_ws;
  size_t off = 0;
  auto take = [&](size_t bytes) { char* q = ws + off; off += (bytes + 255) & ~(size_t)255; return q; };
  p.wtin = (u16*)take((size_t)DEPTH * DIN * 1024 * 2);
  p.wtout = (u16*)take((size_t)DEPTH * 1024 * 1024 * 2);
  p.xg = (u16*)take((size_t)MTOK * DM * 2);
  p.proj = (u16*)take((size_t)MTOK * DIN * 2);
  p.vt = (u16*)take((size_t)NBATCH * NVH * 64 * SEQ * 2);
  p.y = (u16*)take((size_t)MTOK * DM * 2);
  p.ss = (float*)take((size_t)3 * MTOK * 4);
  p.ctr = (unsigned*)take(256);
  p.bar = (unsigned*)take((size_t)XCD_BAR_WORDS * 4);
  p.x2 = (float*)p.proj;
  p.never = 0;
  (void)hipMemsetAsync(p.bar, 0, (size_t)XCD_BAR_WORDS * 4, stream);
  void* args[] = {&p};
  hipError_t e = hipLaunchCooperativeKernel((void*)hymba_mega, dim3(grid_blocks), dim3(256), args, 0, stream);
  if (e != hipSuccess) fprintf(stderr, "cooperative launch failed: %s (grid %d)\n", hipGetErrorString(e), grid_blocks);
}
```
